# Optimizing an MI355X kernel written in HIP

```python
import jax, jax.numpy as jnp
from jax import lax
import numpy as np

D_MODEL = 1024
BATCH = 8
SEQ = 4096
DEPTH = 2

N_Q_HEADS = 16
N_KV_HEADS = 2
HEAD_DIM = 64
WINDOW = 128
ATT_BLOCK = 128
GLA_HEADS = 4
GLA_DK = 128
GLA_DV = 256
GLA_RANK = 16
GLA_GATE_NORMALIZER = 16.0
GLA_CHUNK = 16
D_FF = 2816
N_MOD = 9
EPS = 1e-6

ATT_Q_W = N_Q_HEADS * HEAD_DIM
ATT_KV_W = N_KV_HEADS * HEAD_DIM
GLA_K_W = GLA_HEADS * GLA_DK
GLA_V_W = GLA_HEADS * GLA_DV
IN_SPLIT_SIZES = (ATT_Q_W, ATT_KV_W, ATT_KV_W, GLA_K_W, GLA_K_W, GLA_V_W, GLA_RANK, GLA_V_W, D_MODEL, D_MODEL)
IN_COLS = ATT_Q_W + 2 * ATT_KV_W + 2 * GLA_K_W + 2 * GLA_V_W + GLA_RANK + 2 * D_MODEL

kernel_name = 'hybrid_swa_gla_macaron_adaln'


def rmsnorm(x, gain):
    xf = x.astype(jnp.float32)
    y = xf * lax.rsqrt(jnp.mean(xf * xf, axis=-1, keepdims=True) + EPS)
    return (y * gain.astype(jnp.float32)).astype(x.dtype)


def modulate(h, shift, scale):
    return h * (1 + scale[:, None, :]) + shift[:, None, :]


def swiglu(h, w_in, w_out):
    gate, up = jnp.split(h @ w_in, 2, axis=-1)
    return (jax.nn.silu(gate) * up) @ w_out


def sliding_window_attention(q, k, v, sinks):
    B, S = q.shape[:2]
    nb = S // ATT_BLOCK
    grp = N_Q_HEADS // N_KV_HEADS
    qb = q.reshape(B, nb, ATT_BLOCK, N_KV_HEADS, grp, HEAD_DIM)

    def band(t):
        tb = t.reshape(B, nb, ATT_BLOCK, N_KV_HEADS, HEAD_DIM)
        prev = jnp.concatenate([jnp.zeros_like(tb[:, :1]), tb[:, :-1]], axis=1)
        return jnp.concatenate([prev, tb], axis=2)

    kb, vb = band(k), band(v)
    s = jnp.einsum('bnqhgd,bnkhd->bnhgqk', qb, kb).astype(jnp.float32) * (HEAD_DIM ** -0.5)
    q_pos = jnp.arange(ATT_BLOCK)[:, None] + ATT_BLOCK
    k_pos = jnp.arange(2 * ATT_BLOCK)[None, :]
    dist = q_pos - k_pos
    in_window = (dist >= 0) & (dist < WINDOW)
    key_abs = (jnp.arange(nb)[:, None] - 1) * ATT_BLOCK + k_pos
    mask = in_window[None] & (key_abs >= 0)[:, None, :]
    s = jnp.where(mask[None, :, None, None], s, -jnp.inf)
    sink = sinks.astype(jnp.float32).reshape(N_KV_HEADS, grp)[None, None, :, :, None, None]
    m = jnp.maximum(jnp.max(s, axis=-1, keepdims=True), sink)
    p = jnp.exp(s - m)
    p = p / (jnp.sum(p, axis=-1, keepdims=True) + jnp.exp(sink - m))
    o = jnp.einsum('bnhgqk,bnkhd->bnqhgd', p.astype(v.dtype), vb)
    return o.reshape(B, S, N_Q_HEADS * HEAD_DIM)


def gated_linear_attention(q, k, v, log_a):
    B, S, H, dk = q.shape
    nc = S // GLA_CHUNK

    def chunks(t):
        return t.reshape(B, nc, GLA_CHUNK, H, t.shape[-1]).astype(jnp.float32)

    q = chunks(q) * (dk ** -0.5)
    k, v, g = chunks(k), chunks(v), chunks(log_a)
    G = jnp.cumsum(g, axis=2)
    G_first = G[:, :, :1]
    G_last = G[:, :, -1:]
    q_rel = q * jnp.exp(G - G_first)
    k_rel = k * jnp.exp(G_first - G)
    A = jnp.einsum('bnihd,bnjhd->bnhij', q_rel, k_rel)
    causal = jnp.tril(jnp.ones((GLA_CHUNK, GLA_CHUNK), dtype=bool))
    A = jnp.where(causal, A, 0.0)
    o_intra = jnp.einsum('bnhij,bnjhv->bnihv', A, v)
    qg = q * jnp.exp(G)
    kg = k * jnp.exp(G_last - G)
    decay = jnp.exp(G_last[:, :, 0])

    def step(state, inp):
        qg_c, kg_c, v_c, dec = inp
        o = jnp.einsum('bihd,bhdv->bihv', qg_c, state)
        state = dec[..., None] * state + jnp.einsum('bjhd,bjhv->bhdv', kg_c, v_c)
        return state, o

    state0 = jnp.zeros((B, H, dk, v.shape[-1]), jnp.float32)
    xs = (jnp.moveaxis(qg, 1, 0), jnp.moveaxis(kg, 1, 0), jnp.moveaxis(v, 1, 0), jnp.moveaxis(decay, 1, 0))
    _, o_inter = lax.scan(step, state0, xs)
    o = o_intra + jnp.moveaxis(o_inter, 0, 1)
    return o.reshape(B, S, H, v.shape[-1])


def token_mixer(h, w_in, sinks, w_gate, b_gate, gla_norm, w_out):
    B, S, _ = h.shape
    split_at = [int(i) for i in np.cumsum(IN_SPLIT_SIZES)[:-1]]
    qa, ka, va, qb, kb, vb, lr, r, ga, gb = jnp.split(h @ w_in, split_at, axis=-1)
    ya = sliding_window_attention(qa.reshape(B, S, N_Q_HEADS, HEAD_DIM),
                                  ka.reshape(B, S, N_KV_HEADS, HEAD_DIM),
                                  va.reshape(B, S, N_KV_HEADS, HEAD_DIM), sinks)
    log_a = jax.nn.log_sigmoid((lr @ w_gate + b_gate).astype(jnp.float32)) / GLA_GATE_NORMALIZER
    ob = gated_linear_attention(qb.reshape(B, S, GLA_HEADS, GLA_DK),
                                kb.reshape(B, S, GLA_HEADS, GLA_DK),
                                vb.reshape(B, S, GLA_HEADS, GLA_DV),
                                log_a.reshape(B, S, GLA_HEADS, GLA_DK))
    yb = rmsnorm(ob, gla_norm).reshape(B, S, GLA_V_W).astype(h.dtype) * jax.nn.silu(r)
    merged = jax.nn.sigmoid(ga) * ya + jax.nn.sigmoid(gb) * yb
    return merged @ w_out


def setup_inputs(seed: int = 0) -> dict:
    key = jax.random.key(seed)
    ks = jax.random.split(key, 20)

    def w(k, shape, fan_in, gain=1.0):
        return jax.random.normal(k, shape, jnp.float32) * (gain * fan_in ** -0.5)

    def norm_gain(k, shape):
        return 1.0 + 0.02 * jax.random.normal(k, shape, jnp.float32)

    L = DEPTH
    return {
        'x': jax.random.normal(ks[0], (BATCH, SEQ, D_MODEL), jnp.float32),
        'c': jax.random.normal(ks[1], (BATCH, D_MODEL), jnp.float32),
        'ada_w': w(ks[2], (L, D_MODEL, N_MOD * D_MODEL), D_MODEL, 0.5),
        'ada_b': 0.02 * jax.random.normal(ks[3], (L, N_MOD * D_MODEL), jnp.float32),
        'norm1': norm_gain(ks[4], (L, D_MODEL)),
        'ffn1_w_in': w(ks[5], (L, D_MODEL, 2 * D_FF), D_MODEL),
        'ffn1_w_out': w(ks[6], (L, D_FF, D_MODEL), D_FF),
        'norm_mix': norm_gain(ks[7], (L, D_MODEL)),
        'mix_w_in': w(ks[8], (L, D_MODEL, IN_COLS), D_MODEL),
        'attn_sinks': jax.random.normal(ks[9], (L, N_Q_HEADS), jnp.float32),
        'gla_w_gate': w(ks[10], (L, GLA_RANK, GLA_K_W), GLA_RANK),
        'gla_b_gate': 0.1 * jax.random.normal(ks[11], (L, GLA_K_W), jnp.float32),
        'gla_out_norm': norm_gain(ks[12], (L, GLA_DV)),
        'mix_w_out': w(ks[13], (L, D_MODEL, D_MODEL), D_MODEL),
        'norm2': norm_gain(ks[14], (L, D_MODEL)),
        'ffn2_w_in': w(ks[15], (L, D_MODEL, 2 * D_FF), D_MODEL),
        'ffn2_w_out': w(ks[16], (L, D_FF, D_MODEL), D_FF),
        'final_norm': norm_gain(ks[17], (D_MODEL,)),
    }


def reference(x, c, ada_w, ada_b, norm1, ffn1_w_in, ffn1_w_out, norm_mix, mix_w_in,
              attn_sinks, gla_w_gate, gla_b_gate, gla_out_norm, mix_w_out, norm2,
              ffn2_w_in, ffn2_w_out, final_norm):
    cond = jax.nn.silu(c)
    for l in range(DEPTH):
        mod = cond @ ada_w[l] + ada_b[l]
        sh1, sc1, g1, sh2, sc2, g2, sh3, sc3, g3 = jnp.split(mod, N_MOD, axis=-1)
        h = modulate(rmsnorm(x, norm1[l]), sh1, sc1)
        x = x + 0.5 * g1[:, None, :] * swiglu(h, ffn1_w_in[l], ffn1_w_out[l])
        h = modulate(rmsnorm(x, norm_mix[l]), sh2, sc2)
        x = x + g2[:, None, :] * token_mixer(h, mix_w_in[l], attn_sinks[l], gla_w_gate[l],
                                             gla_b_gate[l], gla_out_norm[l], mix_w_out[l])
        h = modulate(rmsnorm(x, norm2[l]), sh3, sc3)
        x = x + 0.5 * g3[:, None, :] * swiglu(h, ffn2_w_in[l], ffn2_w_out[l])
    return rmsnorm(x, final_norm)
```

```cpp
#include <hip/hip_runtime.h>
#include <hip/hip_cooperative_groups.h>
#include <cstdio>
#include <cstdint>
namespace cg = cooperative_groups;
namespace pg8 {
#define PG8_LAS __attribute__((address_space(3)))
typedef unsigned short bf16_t;
typedef short bf16x8 __attribute__((ext_vector_type(8)));
typedef float f32x4 __attribute__((ext_vector_type(4)));
typedef unsigned u32x4 __attribute__((ext_vector_type(4)));
constexpr int BM = 256, BK = 64, HALF = 128, HTB = HALF * BK * 2  , STAGE_BYTES = 8 * HTB, NXCD = 8, WGM = 8;

__host__ __device__ __forceinline__ int lds_byte(int r, int c) { const int st = (r >> 4) * 2 + (c >> 5), rr = r & 15, cc = c & 31, ob = rr * 64 + cc * 2; return st * 1024 + (ob ^ (((ob >> 9) & 1) << 5)); }
__host__ __device__ __forceinline__ void stage_rc(int b, int& R, int& C) { const int st = b / 1024, sb = b % 1024, swz = sb ^ (((sb >> 9) & 1) << 5); R = (st >> 1) * 16 + swz / 64; C = (st & 1) * 32 + (swz % 64) / 2; }
__host__ __device__ __forceinline__ int perm32(int rho) { const int n = rho >> 4, i = rho & 15; return 8 * (i >> 2) + 4 * n + (i & 3); }

struct Unit { int pm, pn; };
struct Gemm { const bf16_t* A; const bf16_t* Bt; int M, N, K; };

struct StaticOrder {
    int nM, nN, nwg, G, c;
    __host__ __device__ void init(int M, int N, int G_, int c_) { nM = M / BM; nN = N / BM; nwg = nM * nN; G = G_; c = c_; }
    __host__ __device__ bool next(int i, Unit& u) const {
        const long L = (long)i * G + c; if (L >= nwg) return false;
        int wgid = (int)L; { const int q = nwg / NXCD, r = nwg % NXCD, xcd = wgid % NXCD, off = wgid / NXCD; wgid = (xcd < r ? xcd * (q + 1) : r * (q + 1) + (xcd - r) * q) + off; }
        const int nig = WGM * nN, gid = wgid / nig, fm = gid * WGM, gsz = (nM - fm) < WGM ? (nM - fm) : WGM;
        u.pm = fm + ((wgid % nig) % gsz); u.pn = (wgid % nig) / gsz; return true;
    }
    __device__ __forceinline__ void a_ready(const Unit&) const {}
    __device__ __forceinline__ void done(const Unit&) const {}
};
__device__ __forceinline__ unsigned cvt_pk_bf16(float lo, float hi) { typedef float f2_ __attribute__((ext_vector_type(2))); typedef __bf16 b2_ __attribute__((ext_vector_type(2)));
    f2_ v = {lo, hi}; b2_ r = __builtin_convertvector(v, b2_); return __builtin_bit_cast(unsigned, r); }
template <class Epi, class Sched, bool ALIGN_EPI = false, bool SP2 = false>
__device__ __forceinline__ void gemm_phase(PG8_LAS unsigned char* lds, const Gemm g, const Sched& S, const Epi& E) {
    int tid_o = threadIdx.x; asm volatile("" : "+v"(tid_o));
    const int tid = tid_o, wid = __builtin_amdgcn_readfirstlane(tid >> 6), lane = tid & 63, wr = wid >> 2, wc = wid & 3, fr = lane & 15, fq = lane >> 4;
    const int K = g.K, nt = K / BK;
    unsigned voffA[2], voffB[2];
#pragma unroll
    for (int i = 0; i < 2; ++i) { int R, C; stage_rc(tid * 16 + i * 8192, R, C); const int Rb = Epi::PERM ? ((R & ~31) + perm32(R & 31)) : R;
        voffA[i] = (unsigned)(R * K + C) * 2u; voffB[i] = (unsigned)(Rb * K + C) * 2u; }
    const size_t kstep = (size_t)(BK * 2);
    const size_t hstep = (size_t)HALF * K * 2;
    const size_t tstep = 2 * hstep;
    const unsigned ldsw = (unsigned)wid * 1024u;
    const int aoff = lds_byte(wr * 64 + fr, fq * 8), boff = lds_byte(wc * 32 + fr, fq * 8);
#define PG8_SA(b, h) (((b) * 2 + (h)) * HTB)
#define PG8_SB(b, h) ((4 + (b) * 2 + (h)) * HTB)
#define PG8_STAGE(bufoff, gbase, voff) do { _Pragma("unroll") for (int _i = 0; _i < 2; ++_i) \
        __builtin_amdgcn_global_load_lds((const unsigned*)((const char*)(gbase) + (voff)[_i]), (PG8_LAS unsigned*)(lds + (bufoff) + ldsw + _i * 8192), 16, 0, 0); } while (0)
#define PG8_LDA(dst, b, h) do { _Pragma("unroll") for (int m = 0; m < 4; ++m) _Pragma("unroll") for (int k = 0; k < 2; ++k) dst[m][k] = *(const PG8_LAS bf16x8*)(lds + PG8_SA(b, h) + aoff + m * 2048 + k * 1024); } while (0)
#define PG8_LDB(dst, b, h) do { _Pragma("unroll") for (int n = 0; n < 2; ++n) _Pragma("unroll") for (int k = 0; k < 2; ++k) dst[n][k] = *(const PG8_LAS bf16x8*)(lds + PG8_SB(b, h) + boff + n * 2048 + k * 1024); } while (0)
#define PG8_MMA(ai, bj, At, Bt) do { __builtin_amdgcn_s_setprio(1); _Pragma("unroll") for (int m = 0; m < 4; ++m) _Pragma("unroll") for (int n = 0; n < 2; ++n) _Pragma("unroll") for (int k = 0; k < 2; ++k) \
        acc[ai][bj][m][n] = __builtin_amdgcn_mfma_f32_16x16x32_bf16(Bt[n][k], At[m][k], acc[ai][bj][m][n], 0, 0, 0); __builtin_amdgcn_s_setprio(0); } while (0)
#define PG8_WAIT_V(n) asm volatile("s_waitcnt vmcnt(" #n ")" ::: "memory")
#define PG8_WAIT_L(n) asm volatile("s_waitcnt lgkmcnt(" #n ")" ::: "memory")
#define PG8_BAR __builtin_amdgcn_s_barrier()
#define PG8_SCHED __builtin_amdgcn_sched_barrier(0)
    Unit cur, nxt; int ui = 0;
    if (!S.next(0, cur)) return;
    f32x4 acc[2][2][4][2];
#pragma unroll
    for (int a = 0; a < 2; ++a)
#pragma unroll
        for (int b = 0; b < 2; ++b)
#pragma unroll
            for (int m = 0; m < 4; ++m)
#pragma unroll
                for (int n = 0; n < 2; ++n) acc[a][b][m][n] = (f32x4){0.f, 0.f, 0.f, 0.f};
    bf16x8 At[4][2], B0[2][2], B1[2][2];
    const char* cA = (const char*)g.A + (size_t)cur.pm * tstep; const char* cB = (const char*)g.Bt + (size_t)cur.pn * tstep;
    S.a_ready(cur);
    if constexpr (SP2) {
        PG8_STAGE(PG8_SB(0, 0), cB, voffB); PG8_STAGE(PG8_SB(0, 1), cB + hstep, voffB); PG8_STAGE(PG8_SA(0, 0), cA, voffA); PG8_STAGE(PG8_SA(0, 1), cA + hstep, voffA);
        if (wr == 1) PG8_BAR;
        PG8_WAIT_V(2); PG8_BAR;
        PG8_STAGE(PG8_SB(1, 0), cB + kstep, voffB); PG8_STAGE(PG8_SA(1, 0), cA + kstep, voffA); PG8_STAGE(PG8_SB(1, 1), cB + hstep + kstep, voffB);
        PG8_WAIT_V(6); PG8_BAR;
    } else {
        PG8_STAGE(PG8_SB(0, 0), cB, voffB); PG8_STAGE(PG8_SA(0, 0), cA, voffA); PG8_STAGE(PG8_SB(0, 1), cB + hstep, voffB); PG8_STAGE(PG8_SA(0, 1), cA + hstep, voffA);
        if (wr == 1) PG8_BAR;
        PG8_WAIT_V(4); PG8_BAR;
        PG8_STAGE(PG8_SB(1, 0), cB + kstep, voffB); PG8_STAGE(PG8_SA(1, 0), cA + kstep, voffA); PG8_STAGE(PG8_SB(1, 1), cB + hstep + kstep, voffB);
        PG8_WAIT_V(6); PG8_BAR;
    }
    for (;;) {
        const bool has_next = S.next(ui + 1, nxt);
        const char* nA = has_next ? (const char*)g.A + (size_t)nxt.pm * tstep : cA; const char* nB = has_next ? (const char*)g.Bt + (size_t)nxt.pn * tstep : cB;
        for (int t = 0; t < nt; t += 2) {
            const bool last = (t == nt - 2);
            const char* a1 = cA + (size_t)(t + 1) * kstep;
            const char* a2 = last ? nA : cA + (size_t)(t + 2) * kstep; const char* b2 = last ? nB : cB + (size_t)(t + 2) * kstep;
            const char* a3 = a2 + kstep; const char* b3 = b2 + kstep;
            if (last && has_next) S.a_ready(nxt);
            if constexpr (SP2) {
            PG8_LDB(B0, 0, 0); PG8_LDB(B1, 0, 1); PG8_SCHED; PG8_LDA(At, 0, 0); PG8_STAGE(PG8_SA(1, 1), a1 + hstep, voffA);
            PG8_WAIT_V(8); PG8_WAIT_L(0); PG8_BAR; PG8_MMA(0, 0, At, B0); PG8_MMA(0, 1, At, B1); PG8_BAR; PG8_SCHED;
            PG8_LDA(At, 0, 1); PG8_STAGE(PG8_SB(0, 0), b2, voffB); PG8_STAGE(PG8_SB(0, 1), b2 + hstep, voffB); PG8_STAGE(PG8_SA(0, 0), a2, voffA);
            PG8_WAIT_V(8); PG8_WAIT_L(0); PG8_BAR; PG8_MMA(1, 0, At, B0); PG8_MMA(1, 1, At, B1); PG8_BAR; PG8_SCHED;
            PG8_LDB(B0, 1, 0); PG8_LDB(B1, 1, 1); PG8_SCHED; PG8_LDA(At, 1, 0); PG8_STAGE(PG8_SA(0, 1), a2 + hstep, voffA);
            PG8_WAIT_V(8); PG8_WAIT_L(0); PG8_BAR; PG8_MMA(0, 0, At, B0); PG8_MMA(0, 1, At, B1); PG8_BAR; PG8_SCHED;
            PG8_LDA(At, 1, 1); PG8_STAGE(PG8_SB(1, 0), b3, voffB); PG8_STAGE(PG8_SB(1, 1), b3 + hstep, voffB); PG8_STAGE(PG8_SA(1, 0), a3, voffA);
            PG8_WAIT_V(8); PG8_WAIT_L(0); PG8_BAR; PG8_MMA(1, 0, At, B0); PG8_MMA(1, 1, At, B1); PG8_BAR; PG8_SCHED;
            } else {
            PG8_LDB(B0, 0, 0); PG8_SCHED; PG8_LDA(At, 0, 0); PG8_STAGE(PG8_SA(1, 1), a1 + hstep, voffA);
            PG8_WAIT_L(8); PG8_BAR; PG8_WAIT_L(0); PG8_MMA(0, 0, At, B0); PG8_BAR; PG8_SCHED;
            PG8_LDB(B1, 0, 1); PG8_STAGE(PG8_SB(0, 0), b2, voffB);
            PG8_BAR; PG8_WAIT_L(0); PG8_MMA(0, 1, At, B1); PG8_BAR;
            PG8_LDA(At, 0, 1); PG8_STAGE(PG8_SA(0, 0), a2, voffA);
            PG8_BAR; PG8_WAIT_L(0); PG8_MMA(1, 0, At, B0); PG8_BAR; PG8_SCHED;
            PG8_STAGE(PG8_SB(0, 1), b2 + hstep, voffB);
            PG8_WAIT_V(6); PG8_BAR; PG8_MMA(1, 1, At, B1); PG8_BAR;
            PG8_LDB(B0, 1, 0); PG8_SCHED; PG8_LDA(At, 1, 0); PG8_STAGE(PG8_SA(0, 1), a2 + hstep, voffA);
            PG8_WAIT_L(8); PG8_BAR; PG8_WAIT_L(0); PG8_MMA(0, 0, At, B0); PG8_BAR; PG8_SCHED;
            PG8_LDB(B1, 1, 1); PG8_STAGE(PG8_SB(1, 0), b3, voffB);
            PG8_BAR; PG8_WAIT_L(0); PG8_MMA(0, 1, At, B1); PG8_BAR;
            PG8_LDA(At, 1, 1); PG8_STAGE(PG8_SA(1, 0), a3, voffA);
            PG8_BAR; PG8_WAIT_L(0); PG8_MMA(1, 0, At, B0); PG8_BAR; PG8_SCHED;
            PG8_STAGE(PG8_SB(1, 1), b3 + hstep, voffB);
            PG8_WAIT_V(6); PG8_BAR; PG8_MMA(1, 1, At, B1); PG8_BAR;
            }
        }
        if constexpr (ALIGN_EPI) { if (wr == 0) PG8_BAR; }
        if constexpr (!Epi::AFTER_DRAIN) { E(acc, cur, wr, wc, fr, fq); S.done(cur); }
        if (!has_next) break;
#pragma unroll
        for (int a = 0; a < 2; ++a)
#pragma unroll
            for (int b = 0; b < 2; ++b)
#pragma unroll
                for (int m = 0; m < 4; ++m)
#pragma unroll
                    for (int n = 0; n < 2; ++n) acc[a][b][m][n] = (f32x4){0.f, 0.f, 0.f, 0.f};
        cur = nxt; cA = nA; cB = nB; ++ui;
        if constexpr (ALIGN_EPI) { if (wr == 1) PG8_BAR; }
    }
    PG8_WAIT_V(0);
    if constexpr (!ALIGN_EPI) { if (wr == 0) PG8_BAR; }
    PG8_BAR;
    if constexpr (Epi::AFTER_DRAIN) { E.fused(acc, cur, wr, wc, fr, fq, lds, wid, lane); S.done(cur); }
#undef PG8_SA
#undef PG8_SB
#undef PG8_STAGE
#undef PG8_LDA
#undef PG8_LDB
#undef PG8_MMA
#undef PG8_WAIT_V
#undef PG8_WAIT_L
#undef PG8_BAR
#undef PG8_SCHED
}
}

#define LAS __attribute__((address_space(3)))
typedef unsigned short bf16_t;
typedef short bf16x8 __attribute__((ext_vector_type(8)));
typedef short bf16x4 __attribute__((ext_vector_type(4)));
typedef float f32x4 __attribute__((ext_vector_type(4)));
typedef unsigned u32x4 __attribute__((ext_vector_type(4)));
typedef unsigned u32x2 __attribute__((ext_vector_type(2)));
typedef float f32x2_t __attribute__((ext_vector_type(2)));
constexpr int T = 32768, D = 1024, FF = 2816, NFF2 = 5632, SEQ = 4096, NMOD = 9216, INC = 6416;
constexpr int NA = 2304, NAG = 2560, NBG = 4096, NB = 3584;
constexpr float EPS = 1e-6f;
constexpr size_t MiB = 1u << 20;
constexpr size_t WS_CTL = 0, CTL_BYTES = 65536;
constexpr size_t WS_MOD = 65536;
constexpr size_t WS_W = 1 * MiB, WS_WSTRIDE = 49 * MiB;
constexpr size_t W_1IN = 0, W_1OUT = W_1IN + (size_t)NFF2 * D * 2, W_A = W_1OUT + (size_t)D * FF * 2, W_B = W_A + (size_t)NAG * D * 2,
                 W_O = W_B + (size_t)NBG * D * 2, W_2IN = W_O + (size_t)D * D * 2, W_2OUT = W_2IN + (size_t)NFF2 * D * 2, W_END = W_2OUT + (size_t)D * FF * 2;
static_assert(W_END <= 49 * MiB, "weights");
constexpr size_t WS_H = 99 * MiB;
constexpr size_t WS_MRG = 163 * MiB;
constexpr size_t WS_PROJ = 227 * MiB;
static_assert((size_t)T * NB * 2 <= 224 * MiB && (size_t)T * FF * 2 <= 224 * MiB && (size_t)T * NA * 2 <= 224 * MiB, "PROJ region = 224 MiB");
constexpr size_t WS_LR = 451 * MiB;
constexpr int LDS_BYTES = 147456;

__device__ __forceinline__ float bf2f(unsigned v) { return __uint_as_float(v << 16); }
__device__ __forceinline__ float bflo(unsigned v) { return __uint_as_float(v << 16); }
__device__ __forceinline__ float bfhi(unsigned v) { return __uint_as_float(v & 0xffff0000u); }
__device__ __forceinline__ float wave_sum(float v) {
#pragma unroll
    for (int o = 1; o < 64; o <<= 1) v += __shfl_xor(v, o);
    return v;
}
__device__ __forceinline__ float sigm(float v) { return __builtin_amdgcn_rcpf(1.f + __expf(-v)); }
__device__ __forceinline__ f32x4 mfma16(bf16x8 a, bf16x8 b, f32x4 c) { return __builtin_amdgcn_mfma_f32_16x16x32_bf16(a, b, c, 0, 0, 0); }

__device__ __forceinline__ int otid() { int t = threadIdx.x; asm volatile("" : "+v"(t)); return t; }
using pg8::Unit;
struct EpiSwiGLU {
    static constexpr bool PERM = true, AFTER_DRAIN = false;
    bf16_t* O;
    __device__ __forceinline__ void operator()(const f32x4 (&acc)[2][2][4][2], const Unit& u, int wr, int wc, int fr, int fq) const {
        const int row0 = u.pm * 256 + wr * 64 + fr, col0 = u.pn * 128 + wc * 32 + 8 * fq;
#pragma unroll
        for (int ai = 0; ai < 2; ++ai)
#pragma unroll
            for (int m = 0; m < 4; ++m) {
                bf16_t* rowp = O + (size_t)(row0 + ai * 128 + m * 16) * FF + col0;
                float v[8];
#pragma unroll
                for (int n = 0; n < 2; ++n)
#pragma unroll
                    for (int j = 0; j < 4; ++j) { const float g = acc[ai][0][m][n][j], up = acc[ai][1][m][n][j]; v[n * 4 + j] = g * sigm(g) * up; }
                u32x4 w; w.x = pg8::cvt_pk_bf16(v[0], v[1]); w.y = pg8::cvt_pk_bf16(v[2], v[3]); w.z = pg8::cvt_pk_bf16(v[4], v[5]); w.w = pg8::cvt_pk_bf16(v[6], v[7]);
                *(u32x4*)rowp = w;
            }
    }
};
struct EpiResid {
    static constexpr bool PERM = true, AFTER_DRAIN = false;
    bf16_t* Dl; const float* gate; float coef;
    __device__ __forceinline__ void operator()(const f32x4 (&acc)[2][2][4][2], const Unit& u, int wr, int wc, int fr, int fq) const {
        const int row0 = u.pm * 256 + wr * 64 + fr, b = u.pm >> 4;
#pragma unroll
        for (int bj = 0; bj < 2; ++bj) {
            const int col0 = u.pn * 256 + bj * 128 + wc * 32 + 8 * fq;
            const f32x4 g0 = *(const f32x4*)(gate + (size_t)b * NMOD + col0) * coef, g1 = *(const f32x4*)(gate + (size_t)b * NMOD + col0 + 4) * coef;
#pragma unroll
            for (int ai = 0; ai < 2; ++ai)
#pragma unroll
                for (int m = 0; m < 4; ++m) { const f32x4 v0 = acc[ai][bj][m][0] * g0, v1 = acc[ai][bj][m][1] * g1;
                    u32x4 w; w.x = pg8::cvt_pk_bf16(v0[0], v0[1]); w.y = pg8::cvt_pk_bf16(v0[2], v0[3]); w.z = pg8::cvt_pk_bf16(v1[0], v1[1]); w.w = pg8::cvt_pk_bf16(v1[2], v1[3]);
                    *(u32x4*)(Dl + (size_t)(row0 + ai * 128 + m * 16) * D + col0) = w; }
        }
    }
};
struct EpiProj {
    static constexpr bool PERM = true, AFTER_DRAIN = false;
    bf16_t* O; int ldc; int mode; float* LR;
    __device__ __forceinline__ void operator()(const f32x4 (&acc)[2][2][4][2], const Unit& u, int wr, int wc, int fr, int fq) const {
        const int row0 = u.pm * 256 + wr * 64 + fr;
        if (mode == 0 && u.pn == 9) {
            if (wc == 0 && fq < 2) {
#pragma unroll
                for (int ai = 0; ai < 2; ++ai)
#pragma unroll
                    for (int m = 0; m < 4; ++m) { float* lp = LR + (size_t)(row0 + ai * 128 + m * 16) * 16 + 8 * fq; *(f32x4*)lp = acc[ai][0][m][0]; *(f32x4*)(lp + 4) = acc[ai][0][m][1]; }
            }
            return;
        }
        if (mode == 1 && u.pn >= 8 && u.pn < 16) {
            const int col0 = 2048 + 128 * (u.pn - 8) + wc * 32 + 8 * fq;
#pragma unroll
            for (int ai = 0; ai < 2; ++ai)
#pragma unroll
                for (int m = 0; m < 4; ++m) {
                    float v[8];
#pragma unroll
                    for (int n = 0; n < 2; ++n)
#pragma unroll
                        for (int j = 0; j < 4; ++j) { const float r_ = acc[ai][0][m][n][j], g_ = acc[ai][1][m][n][j]; v[n * 4 + j] = r_ * sigm(r_) * sigm(g_); }
                    u32x4 w; w.x = pg8::cvt_pk_bf16(v[0], v[1]); w.y = pg8::cvt_pk_bf16(v[2], v[3]); w.z = pg8::cvt_pk_bf16(v[4], v[5]); w.w = pg8::cvt_pk_bf16(v[6], v[7]);
                    *(u32x4*)(O + (size_t)(row0 + ai * 128 + m * 16) * ldc + col0) = w;
                }
            return;
        }
#pragma unroll
        for (int bj = 0; bj < 2; ++bj) {
            const int c0 = u.pn * 256 + bj * 128;
            int code, oc0 = c0; float sc = 1.f;
            if (mode == 0) { if (c0 < 1024) { code = 0; sc = 0.125f; } else if (c0 < 1280) code = 0; else code = 1; }
            else { code = 0; if (c0 < 512) sc = 0.08838834764831845f; }
            const int col0 = oc0 + wc * 32 + 8 * fq;
#pragma unroll
            for (int ai = 0; ai < 2; ++ai)
#pragma unroll
                for (int m = 0; m < 4; ++m) {
                    float v[8];
#pragma unroll
                    for (int n = 0; n < 2; ++n)
#pragma unroll
                        for (int j = 0; j < 4; ++j) { float x = acc[ai][bj][m][n][j];
                            if (code == 0) x = x * sc;
                            else x = sigm(x);
                            v[n * 4 + j] = x; }
                    u32x4 w; w.x = pg8::cvt_pk_bf16(v[0], v[1]); w.y = pg8::cvt_pk_bf16(v[2], v[3]); w.z = pg8::cvt_pk_bf16(v[4], v[5]); w.w = pg8::cvt_pk_bf16(v[6], v[7]);
                    *(u32x4*)(O + (size_t)(row0 + ai * 128 + m * 16) * ldc + col0) = w;
                }
        }
    }
};

__device__ __forceinline__ void transpose_item(const float* W, int Nsrc, int K, bf16_t* WT, int k0, int srccol0, int dstrow0, LAS float* scr, int lane) {
#pragma unroll 8
    for (int i = 0; i < 32; ++i) { const int kk = 2 * i + (lane >> 5); scr[kk * 33 + (lane & 31)] = W[(size_t)(k0 + kk) * Nsrc + srccol0 + (lane & 31)]; }
    asm volatile("s_waitcnt lgkmcnt(0)" ::: "memory");
    const int c = lane & 7;
#pragma unroll
    for (int j = 0; j < 4; ++j) { const int n = (lane >> 3) + 8 * j; const LAS float* s = scr + (8 * c) * 33 + n;
        u32x4 o; o.x = pg8::cvt_pk_bf16(s[0 * 33], s[1 * 33]); o.y = pg8::cvt_pk_bf16(s[2 * 33], s[3 * 33]); o.z = pg8::cvt_pk_bf16(s[4 * 33], s[5 * 33]); o.w = pg8::cvt_pk_bf16(s[6 * 33], s[7 * 33]);
        *(u32x4*)(WT + (size_t)(dstrow0 + n) * K + k0 + 8 * c) = o; }
    asm volatile("s_waitcnt lgkmcnt(0)" ::: "memory");
}
__device__ __forceinline__ int map_src(int mapid, int r) {
    if (mapid == 1) { const int pn = r >> 8, bj = (r >> 7) & 1, j = r & 127; return bj * FF + 128 * pn + j; }
    if (mapid == 2) return r < 1280 ? r : (r < 2304 ? r + 3088 : 3328 + (r - 2304));
    if (mapid == 3) { if (r < 2048) return r + 1280; const int rr = r - 2048, t = rr >> 8, bj = (rr >> 7) & 1, j = rr & 127; return (bj ? 5392 : 3344) + 128 * t + j; }
    return r;
}
struct ConvItem { const float* W; bf16_t* WT; int Nsrc, K, k0, srccol0, dstrow0; };
__device__ __forceinline__ void tr_load(const ConvItem& ci, int lane, float (&tv)[32]) {
#pragma unroll
    for (int i = 0; i < 32; ++i) { const int kk = 2 * i + (lane >> 5); tv[i] = ci.W[(size_t)(ci.k0 + kk) * ci.Nsrc + ci.srccol0 + (lane & 31)]; }
}
__device__ __forceinline__ void tr_finish(const ConvItem& ci, int lane, const float (&tv)[32], LAS float* scr) {
#pragma unroll
    for (int i = 0; i < 32; ++i) { const int kk = 2 * i + (lane >> 5); scr[kk * 33 + (lane & 31)] = tv[i]; }
    asm volatile("s_waitcnt lgkmcnt(0)" ::: "memory");
    const int c = lane & 7;
#pragma unroll
    for (int j = 0; j < 4; ++j) { const int n = (lane >> 3) + 8 * j; const LAS float* s = scr + (8 * c) * 33 + n;
        u32x4 o; o.x = pg8::cvt_pk_bf16(s[0 * 33], s[1 * 33]); o.y = pg8::cvt_pk_bf16(s[2 * 33], s[3 * 33]); o.z = pg8::cvt_pk_bf16(s[4 * 33], s[5 * 33]); o.w = pg8::cvt_pk_bf16(s[6 * 33], s[7 * 33]);
        *(u32x4*)(ci.WT + (size_t)(ci.dstrow0 + n) * ci.K + ci.k0 + 8 * c) = o; }
    asm volatile("s_waitcnt lgkmcnt(0)" ::: "memory");
}
__device__ __forceinline__ bool conv_try(int& it, const float* W, int Nsrc, int K, bf16_t* WT, int ndst, int mapid, LAS float* scr, int lane) {
    const int ng = ndst / 32, n = (K / 64) * ng;
    if (it >= n) { it -= n; return false; }
    const int kb = it / ng, g = it % ng;
    transpose_item(W, Nsrc, K, WT, 64 * kb, map_src(mapid, 32 * g), 32 * g, scr, lane);
    return true;
}
struct LayerW { const float *f1in, *f1out, *mixin, *wgate, *mixout, *f2in, *f2out; };
constexpr int CONV_NITEMS = 2 * (16 * 176) + 2 * (44 * 32) + 16 * 80 + 16 * 128 + 16 * 32;
__device__ __forceinline__ bool conv_pick(int& it, const float* W, int Nsrc, int K, bf16_t* WT, int ndst, int mapid, ConvItem& ci) {
    const int ng = ndst / 32, n = (K / 64) * ng;
    if (it >= n) { it -= n; return false; }
    const int kb = it / ng, g = it % ng;
    ci.W = W; ci.WT = WT; ci.Nsrc = Nsrc; ci.K = K; ci.k0 = 64 * kb; ci.srccol0 = map_src(mapid, 32 * g); ci.dstrow0 = 32 * g; return true;
}
constexpr int CONV_LATE = 16 * 176 + 44 * 32 + 16 * 32;
__device__ __forceinline__ ConvItem conv_decode_late(int it, const LayerW& L, unsigned char* wsw) {
    ConvItem ci;
    if (conv_pick(it, L.f2in, NFF2, D, (bf16_t*)(wsw + W_2IN), NFF2, 1, ci)) return ci;
    if (conv_pick(it, L.f2out, D, FF, (bf16_t*)(wsw + W_2OUT), D, 0, ci)) return ci;
    conv_pick(it, L.mixout, D, D, (bf16_t*)(wsw + W_O), D, 0, ci); return ci;
}
__device__ __forceinline__ ConvItem conv_decode(int it, const LayerW& L, unsigned char* wsw) {
    ConvItem ci;
    if (conv_pick(it, L.f1in, NFF2, D, (bf16_t*)(wsw + W_1IN), NFF2, 1, ci)) return ci;
    if (conv_pick(it, L.f2in, NFF2, D, (bf16_t*)(wsw + W_2IN), NFF2, 1, ci)) return ci;
    if (conv_pick(it, L.f1out, D, FF, (bf16_t*)(wsw + W_1OUT), D, 0, ci)) return ci;
    if (conv_pick(it, L.f2out, D, FF, (bf16_t*)(wsw + W_2OUT), D, 0, ci)) return ci;
    if (conv_pick(it, L.mixin, INC, D, (bf16_t*)(wsw + W_A), NAG, 2, ci)) return ci;
    if (conv_pick(it, L.mixin, INC, D, (bf16_t*)(wsw + W_B), 4096, 3, ci)) return ci;
    conv_pick(it, L.mixout, D, D, (bf16_t*)(wsw + W_O), D, 0, ci); return ci;
}
__device__ __forceinline__ void wconv_phase(LAS unsigned char* lds, const LayerW& L, unsigned char* wsw, int vwg, int G) {
    const int tid = otid(), lane = tid & 63, wave = __builtin_amdgcn_readfirstlane(tid >> 6);
    LAS float* scr = (LAS float*)(lds + wave * 8704);
    const int gw = vwg * 8 + wave, NGW = G * 8;
    constexpr int NITEMS = 16 * 176 + 44 * 32 + 16 * 80 + 16 * 128;
    for (int it0 = gw; it0 < NITEMS; it0 += NGW) {
        int it = it0;
        if (conv_try(it, L.f1in, NFF2, D, (bf16_t*)(wsw + W_1IN), NFF2, 1, scr, lane)) continue;
        if (conv_try(it, L.f1out, D, FF, (bf16_t*)(wsw + W_1OUT), D, 0, scr, lane)) continue;
        if (conv_try(it, L.mixin, INC, D, (bf16_t*)(wsw + W_A), NAG, 2, scr, lane)) continue;
        conv_try(it, L.mixin, INC, D, (bf16_t*)(wsw + W_B), 4096, 3, scr, lane);
    }
}
__device__ __forceinline__ void mod_phase(LAS unsigned char* lds, const float* c, const float* ada_w, const float* ada_b, float* MOD, int vwg, int G, int l) {
    const int tid = otid(), lane = tid & 63, wave = __builtin_amdgcn_readfirstlane(tid >> 6);
    LAS float* cond = (LAS float*)lds;
    LAS float* red = (LAS float*)(lds + 32768);
    for (int i = tid; i < 8 * D; i += 512) { const float v = c[i]; cond[i] = v * sigm(v); }
    __syncthreads();
    for (int item = vwg; item < NMOD / 64; item += G) {
        const int n0 = item * 64;
        const float* wp = ada_w + (size_t)l * D * NMOD + (size_t)(wave * 128) * NMOD + n0 + lane;
        float acc[8];
#pragma unroll
        for (int b = 0; b < 8; ++b) acc[b] = 0.f;
        for (int k4 = 0; k4 < 32; ++k4) {
            float wv[4];
#pragma unroll
            for (int j = 0; j < 4; ++j) wv[j] = wp[(size_t)(k4 * 4 + j) * NMOD];
#pragma unroll
            for (int b = 0; b < 8; ++b) { const f32x4 cv = *(const LAS f32x4*)(cond + b * D + wave * 128 + k4 * 4); acc[b] += cv[0] * wv[0] + cv[1] * wv[1] + cv[2] * wv[2] + cv[3] * wv[3]; }
        }
#pragma unroll
        for (int b = 0; b < 8; ++b) red[(wave * 8 + b) * 64 + lane] = acc[b];
        __syncthreads();
        { const int b = tid >> 6; float s = ada_b[(size_t)l * NMOD + n0 + lane];
#pragma unroll
          for (int w = 0; w < 8; ++w) s += red[(w * 8 + b) * 64 + lane];
          MOD[((size_t)l * 8 + b) * NMOD + n0 + lane] = s; }
        __syncthreads();
    }
}

__device__ __forceinline__ void norm_phase(const float* Xin, float* Xout, bf16_t* H, int has_delta, const float* gain, const float* shift, const float* scale, int vwg, int G) {
    const int tid_ = otid(), lane = tid_ & 63, wave = __builtin_amdgcn_readfirstlane(tid_ >> 6);
    for (int rg = vwg * 8 + wave; rg < T / 16; rg += G * 8) {
        const int row0 = rg * 16, b = row0 / SEQ;
        f32x4 A[4], Bs[4];
#pragma unroll
        for (int j = 0; j < 4; ++j) { const int cidx = 4 * lane + 256 * j; const f32x4 g = *(const f32x4*)(gain + cidx), sc = *(const f32x4*)(scale + (size_t)b * NMOD + cidx);
            A[j] = g * (sc + 1.0f); Bs[j] = *(const f32x4*)(shift + (size_t)b * NMOD + cidx); }
        for (int r = 0; r < 16; ++r) {
            const f32x4* xr = (const f32x4*)(Xin + (size_t)(row0 + r) * D) + lane;
            u32x2* o8 = (u32x2*)(H + (size_t)(row0 + r) * D) + lane;
            f32x4 v[4]; float s = 0.f;
#pragma unroll
            for (int j = 0; j < 4; ++j) { v[j] = xr[64 * j];
                if (has_delta) { const u32x2 d = o8[64 * j]; v[j] += (f32x4){bflo(d.x), bfhi(d.x), bflo(d.y), bfhi(d.y)}; }
                s += (v[j][0] * v[j][0] + v[j][1] * v[j][1]) + (v[j][2] * v[j][2] + v[j][3] * v[j][3]); }
            if (has_delta) { f32x4* xo = (f32x4*)(Xout + (size_t)(row0 + r) * D) + lane;
#pragma unroll
                for (int j = 0; j < 4; ++j) xo[64 * j] = v[j]; }
            const float rstd = 1.0f / sqrtf(wave_sum(s) * (1.f / D) + EPS);
#pragma unroll
            for (int j = 0; j < 4; ++j) { const f32x4 y = (v[j] * rstd) * A[j] + Bs[j]; u32x2 w; w.x = pg8::cvt_pk_bf16(y[0], y[1]); w.y = pg8::cvt_pk_bf16(y[2], y[3]); o8[64 * j] = w; }
        }
    }
}
__device__ __forceinline__ void final_norm_phase(float* X, const bf16_t* H, const float* gain, int vwg, int G) {
    const int tid_ = otid(), lane = tid_ & 63, wave = __builtin_amdgcn_readfirstlane(tid_ >> 6);
    f32x4 A[4];
#pragma unroll
    for (int j = 0; j < 4; ++j) A[j] = *(const f32x4*)(gain + 4 * lane + 256 * j);
    for (int row = vwg * 8 + wave; row < T; row += G * 8) {
        f32x4* xr = (f32x4*)(X + (size_t)row * D) + lane; const u32x2* dr = (const u32x2*)(H + (size_t)row * D) + lane;
        f32x4 v[4]; float s = 0.f;
#pragma unroll
        for (int j = 0; j < 4; ++j) { const u32x2 d = dr[64 * j]; v[j] = xr[64 * j] + (f32x4){bflo(d.x), bfhi(d.x), bflo(d.y), bfhi(d.y)}; s += (v[j][0] * v[j][0] + v[j][1] * v[j][1]) + (v[j][2] * v[j][2] + v[j][3] * v[j][3]); }
        const float rstd = 1.0f / sqrtf(wave_sum(s) * (1.f / D) + EPS);
#pragma unroll
        for (int j = 0; j < 4; ++j) xr[64 * j] = (v[j] * rstd) * A[j];
    }
}

__device__ __forceinline__ __amdgpu_buffer_rsrc_t mk_rsrc(const void* p) { return __builtin_amdgcn_make_buffer_rsrc((void*)p, 0, 0x7fffffff, 0x00020000); }
__device__ __forceinline__ void att_phase(LAS unsigned char* lds, const bf16_t* PA, bf16_t* MRG, const float* sinks, int vwg, int G, int do_conv, const LayerW& Lc, unsigned char* wswc, const LayerW& Ln, unsigned char* wswn) {
    const int tid = otid(), lane = tid & 63, w = __builtin_amdgcn_readfirstlane(tid >> 6), lr = lane & 15, lq = lane >> 4;
    LAS unsigned char* Kimg = lds;
    LAS unsigned char* VT = lds + 36864;
    const __amdgpu_buffer_rsrc_t rPA = mk_rsrc(PA), rMR = mk_rsrc(MRG);
    const unsigned qvo = ((unsigned)lr * NA + 8u * lq) * 2u;
    const unsigned gvo = ((unsigned)lr * NA + 4u * lq) * 2u;
    const unsigned ovo = ((unsigned)lr * D + 4u * lq) * 2u;
    for (int e = tid; e < 64 * 16; e += 512) *(LAS bf16_t*)(VT + (e >> 4) * 560 + (256 + (e & 15)) * 2) = 0;
    LAS float* cscr = (LAS float*)(lds + 72704 + w * 8448);
    const int cgw = vwg * 8 + w, cNGW = G * 8; int cslot = 0;
    for (int item = vwg; item < 512; item += G) {
        const int g = item & 1, nbk = (item >> 1) & 31, b = item >> 6;
        const int t0 = b * SEQ + nbk * 128;
        const int hq = 8 * g + w;
        u32x4 qn0 = __builtin_amdgcn_raw_buffer_load_b128(rPA, qvo, (t0 * NA + hq * 64) * 2, 0), qn1 = __builtin_amdgcn_raw_buffer_load_b128(rPA, qvo, (t0 * NA + hq * 64 + 32) * 2, 0);
        u32x2 gn_[4];
#pragma unroll
        for (int dt = 0; dt < 4; ++dt) gn_[dt] = __builtin_amdgcn_raw_buffer_load_b64(rPA, gvo, (t0 * NA + 1280 + hq * 64 + 16 * dt) * 2, 0);
        __syncthreads();
#pragma unroll
        for (int c = 0; c < 4; ++c) {
            const int id = tid + 512 * c, row = id >> 3, piece = id & 7;
            u32x4 kv = {0u, 0u, 0u, 0u}, vv = {0u, 0u, 0u, 0u};
            if (nbk > 0 || row >= 128) { const bf16_t* p = PA + (size_t)(t0 - 128 + row) * NA + 1024 + 64 * g + 8 * piece; kv = *(const u32x4*)p; vv = *(const u32x4*)(p + 128); }
            *(LAS u32x4*)(Kimg + row * 144 + piece * 16) = kv;
            LAS bf16_t* vt = (LAS bf16_t*)VT + (8 * piece) * 280 + row;
            vt[0 * 280] = (bf16_t)(vv.x & 0xffffu); vt[1 * 280] = (bf16_t)(vv.x >> 16); vt[2 * 280] = (bf16_t)(vv.y & 0xffffu); vt[3 * 280] = (bf16_t)(vv.y >> 16);
            vt[4 * 280] = (bf16_t)(vv.z & 0xffffu); vt[5 * 280] = (bf16_t)(vv.z >> 16); vt[6 * 280] = (bf16_t)(vv.w & 0xffffu); vt[7 * 280] = (bf16_t)(vv.w >> 16);
        }
        __syncthreads();
        const float sink = sinks[hq];
        for (int mt = 0; mt < 8; ++mt) {
            const bf16x8 qf0 = __builtin_bit_cast(bf16x8, qn0), qf1 = __builtin_bit_cast(bf16x8, qn1);
            u32x2 gc[4];
#pragma unroll
            for (int dt = 0; dt < 4; ++dt) gc[dt] = gn_[dt];
            if (mt + 1 < 8) {
                const int tn = (t0 + 16 * (mt + 1)) * NA;
                qn0 = __builtin_amdgcn_raw_buffer_load_b128(rPA, qvo, (tn + hq * 64) * 2, 0); qn1 = __builtin_amdgcn_raw_buffer_load_b128(rPA, qvo, (tn + hq * 64 + 32) * 2, 0);
#pragma unroll
                for (int dt = 0; dt < 4; ++dt) gn_[dt] = __builtin_amdgcn_raw_buffer_load_b64(rPA, gvo, (tn + 1280 + hq * 64 + 16 * dt) * 2, 0);
            }
            const int cit = cgw + cslot * cNGW; const bool cdo = do_conv && cit < CONV_LATE + CONV_NITEMS;
            ConvItem ci; float tv[32];
            if (cdo) { ci = (cit < CONV_LATE) ? conv_decode_late(cit, Lc, wswc) : conv_decode(cit - CONV_LATE, Ln, wswn); tr_load(ci, lane, tv); }
            f32x4 s[9];
#pragma unroll
            for (int a = 0; a < 9; ++a) {
                const LAS unsigned char* kp = Kimg + (16 * (mt + a) + lr) * 144 + lq * 16;
                const bf16x8 k0 = *(const LAS bf16x8*)kp, k1 = *(const LAS bf16x8*)(kp + 64);
                f32x4 z = {0.f, 0.f, 0.f, 0.f};
                z = mfma16(k0, qf0, z); z = mfma16(k1, qf1, z); s[a] = z;
            }
            const int i = 16 * mt + lr;
            float mx = sink;
#pragma unroll
            for (int a = 0; a < 9; ++a)
#pragma unroll
                for (int r = 0; r < 4; ++r) { const int j = 16 * (mt + a) + 4 * lq + r, dd = j - i; const bool valid = (dd >= 1) && (dd <= 128) && (nbk > 0 || j >= 128);
                    const float v = valid ? s[a][r] : -INFINITY; s[a][r] = v; mx = fmaxf(mx, v); }
            mx = fmaxf(mx, __shfl_xor(mx, 16)); mx = fmaxf(mx, __shfl_xor(mx, 32));
            float sum = 0.f;
#pragma unroll
            for (int a = 0; a < 9; ++a)
#pragma unroll
                for (int r = 0; r < 4; ++r) { const float p = __expf(s[a][r] - mx); s[a][r] = p; sum += p; }
            sum += __shfl_xor(sum, 16); sum += __shfl_xor(sum, 32);
            const float inv = 1.0f / (sum + __expf(sink - mx));
            bf16x8 pf[5];
#pragma unroll
            for (int kk = 0; kk < 5; ++kk) {
                u32x4 wv; wv.x = pg8::cvt_pk_bf16(s[2 * kk][0] * inv, s[2 * kk][1] * inv); wv.y = pg8::cvt_pk_bf16(s[2 * kk][2] * inv, s[2 * kk][3] * inv);
                if (kk < 4) { wv.z = pg8::cvt_pk_bf16(s[2 * kk + 1][0] * inv, s[2 * kk + 1][1] * inv); wv.w = pg8::cvt_pk_bf16(s[2 * kk + 1][2] * inv, s[2 * kk + 1][3] * inv); } else { wv.z = 0u; wv.w = 0u; }
                pf[kk] = __builtin_bit_cast(bf16x8, wv);
            }
#pragma unroll
            for (int dt = 0; dt < 4; ++dt) {
                f32x4 o = {0.f, 0.f, 0.f, 0.f};
#pragma unroll
                for (int kk = 0; kk < 5; ++kk) {
                    const LAS unsigned char* vp = VT + (16 * dt + lr) * 560 + (16 * (mt + 2 * kk) + 4 * lq) * 2;
                    const bf16x4 v0 = *(const LAS bf16x4*)vp, v1 = *(const LAS bf16x4*)(vp + 32);
                    const bf16x8 vf = __builtin_shufflevector(v0, v1, 0, 1, 2, 3, 4, 5, 6, 7);
                    o = mfma16(vf, pf[kk], o);
                }
                const u32x2 ga = gc[dt];
                u32x2 ow; ow.x = pg8::cvt_pk_bf16(o[0] * bflo(ga.x), o[1] * bfhi(ga.x)); ow.y = pg8::cvt_pk_bf16(o[2] * bflo(ga.y), o[3] * bfhi(ga.y));
                __builtin_amdgcn_raw_buffer_store_b64(ow, rMR, ovo, ((t0 + 16 * mt) * D + hq * 64 + 16 * dt) * 2, 0);
            }
            if (cdo) tr_finish(ci, lane, tv, cscr);
            ++cslot;
        }
    }
    if (do_conv) {
        for (; cgw + cslot * cNGW < CONV_LATE + CONV_NITEMS; ++cslot) { const int cit = cgw + cslot * cNGW; float tv[32];
            const ConvItem ci = (cit < CONV_LATE) ? conv_decode_late(cit, Lc, wswc) : conv_decode(cit - CONV_LATE, Ln, wswn);
            tr_load(ci, lane, tv); tr_finish(ci, lane, tv, cscr); }
    }
}

#define LDS_BAR0() do { asm volatile("s_waitcnt lgkmcnt(0)" ::: "memory"); __builtin_amdgcn_s_barrier(); asm volatile("" ::: "memory"); } while (0)
constexpr int G2_QG = 0, G2_KR = 17408, G2_KGT = 34816, G2_VT = 53248, G2_AT = 90112, G2_DEC = 99328, G2_TOT = 99840, G2_RED = 103936, G2_DSG = 105984, G2_LRS = 110080;
template <int PASS>
__device__ __forceinline__ void gla2_phase(LAS unsigned char* lds, const bf16_t* PB, bf16_t* MRG, float* SLOC, float* DSEG, const float* gn, int vwg, int G, bf16_t* MRGO, const float* LRp, const float* wgp, const float* bgp) {
    const int tid = otid(), lane = tid & 63, w = __builtin_amdgcn_readfirstlane(tid >> 6), lr = lane & 15, lq = lane >> 4;
    LAS unsigned char *QG = lds + G2_QG, *KR = lds + G2_KR, *KGT = lds + G2_KGT, *VT = lds + G2_VT, *AT = lds + G2_AT;
    LAS float* DEC = (LAS float*)(lds + G2_DEC); LAS float* TOT = (LAS float*)(lds + G2_TOT); LAS float* RED = (LAS float*)(lds + G2_RED); LAS float* DSG = (LAS float*)(lds + G2_DSG); LAS float* LRS = (LAS float*)(lds + G2_LRS);
    const __amdgpu_buffer_rsrc_t rPB = mk_rsrc(PB), rMR = mk_rsrc(MRG), rSL = mk_rsrc(SLOC), rMO = mk_rsrc(MRGO), rLR = mk_rsrc(LRp);
    for (int item = vwg; item < 256; item += G) {
        const int seg = item & 7, bh = item >> 3, h = bh & 3, b = bh >> 2;
        const size_t tb = (size_t)b * SEQ + (size_t)seg * 512;
        f32x4 st[8][2];
#pragma unroll
        for (int dt = 0; dt < 8; ++dt) { st[dt][0] = (f32x4){0.f, 0.f, 0.f, 0.f}; st[dt][1] = (f32x4){0.f, 0.f, 0.f, 0.f}; }
        __syncthreads();
        if (PASS == 2 && seg > 0) {
            if (tid < 128) for (int sp = 0; sp < seg; ++sp) DSG[sp * 128 + tid] = DSEG[(size_t)(bh * 8 + sp) * 128 + tid];
            const unsigned slo = (unsigned)lane * 4u;
            float cur[64];
            { const int slu = ((bh * 8 + 0) * 8 + w) * 64 * 256;
#pragma unroll
              for (int q = 0; q < 64; ++q) cur[q] = __uint_as_float(__builtin_amdgcn_raw_buffer_load_b32(rSL, slo, slu + q * 256, 0)); }
            __syncthreads();
            for (int sp = 0; sp < seg; ++sp) {
                const int slun = ((bh * 8 + (sp + 1 < seg ? sp + 1 : sp)) * 8 + w) * 64 * 256;
#pragma unroll
                for (int dt = 0; dt < 8; ++dt) { const f32x4 dc = *(const LAS f32x4*)(DSG + sp * 128 + 16 * dt + 4 * lq);
#pragma unroll
                    for (int vt = 0; vt < 2; ++vt)
#pragma unroll
                        for (int r = 0; r < 4; ++r) { const int q = (dt * 2 + vt) * 4 + r; st[dt][vt][r] = st[dt][vt][r] * dc[r] + cur[q];
                            cur[q] = __uint_as_float(__builtin_amdgcn_raw_buffer_load_b32(rSL, slo, slun + q * 256, 0)); } }
            }
            __syncthreads();
        }
        const int dp = tid & 63, part = w, tp = tid & 31, cgp = tid >> 5;
        const int qub = (int)(((tb + 8 * part) * NB + h * 128) * 2);
        const unsigned qvo = (unsigned)dp * 4u;
        const int vub = (int)((tb * NB + 1024 + h * 256) * 2);
        const unsigned vvo = ((unsigned)(2 * tp) * NB + 16u * cgp) * 2u;
        const unsigned evo = ((unsigned)lr * NB + 4u * lq) * 2u, mvo = ((unsigned)lr * D + 4u * lq) * 2u;
        float segdec0 = 1.f, segdec1 = 1.f;
        float wg0[16], wg1[16], bg0 = 0.f, bg1 = 0.f; u32x4 lrn = {0u, 0u, 0u, 0u};
        if (PASS == 1) {
#pragma unroll
            for (int r = 0; r < 16; ++r) { const f32x2_t t = *(const f32x2_t*)(wgp + r * 512 + h * 128 + 2 * dp); wg0[r] = t.x; wg1[r] = t.y; }
            { const f32x2_t t = *(const f32x2_t*)(bgp + h * 128 + 2 * dp); bg0 = t.x; bg1 = t.y; }
            if (tid < 256) lrn = __builtin_amdgcn_raw_buffer_load_b128(rLR, (unsigned)tid * 16u, (int)(tb * 64), 0);
        }
        unsigned rq[8], rk[8], rg[8]; u32x4 rv[4];
#pragma unroll
        for (int e = 0; e < 8; ++e) { const int p = qub + e * NB * 2; if (PASS == 2) rq[e] = __builtin_amdgcn_raw_buffer_load_b32(rPB, qvo, p, 0); rk[e] = __builtin_amdgcn_raw_buffer_load_b32(rPB, qvo, p + 1024, 0); if (PASS == 2) rg[e] = __builtin_amdgcn_raw_buffer_load_b32(rPB, qvo, p + 6144, 0); }
#pragma unroll
        for (int e = 0; e < 2; ++e) { const int p = vub + e * NB * 2; rv[2 * e] = __builtin_amdgcn_raw_buffer_load_b128(rPB, vvo, p, 0); rv[2 * e + 1] = __builtin_amdgcn_raw_buffer_load_b128(rPB, vvo, p + 16, 0); }
        for (int c = 0; c < 8; ++c) {
            if (PASS == 1) {
                if (tid < 256) *(LAS u32x4*)(LRS + tid * 4) = lrn;
                if (c + 1 < 8 && tid < 256) lrn = __builtin_amdgcn_raw_buffer_load_b128(rLR, (unsigned)tid * 16u, (int)((tb + 64 * (c + 1)) * 64), 0);
                LDS_BAR0();
#pragma unroll
                for (int e = 0; e < 8; ++e) {
                    const LAS f32x4* lp = (const LAS f32x4*)(LRS + (8 * part + e) * 16);
                    float s0 = bg0, s1 = bg1;
#pragma unroll
                    for (int q = 0; q < 4; ++q) { const f32x4 lv = lp[q];
#pragma unroll
                        for (int j = 0; j < 4; ++j) { s0 += lv[j] * wg0[4 * q + j]; s1 += lv[j] * wg1[4 * q + j]; } }
                    const float a0 = (fminf(s0, 0.f) - __logf(1.f + __expf(-fabsf(s0)))) * 0.0625f, a1 = (fminf(s1, 0.f) - __logf(1.f + __expf(-fabsf(s1)))) * 0.0625f;
                    rg[e] = pg8::cvt_pk_bf16(a0, a1);
                    __builtin_amdgcn_raw_buffer_store_b32(rg[e], rPB, qvo, qub + (64 * c + e) * NB * 2 + 6144, 0);
                }
            }
            float G0[8], G1[8]; float run0 = 0.f, run1 = 0.f;
#pragma unroll
            for (int e = 0; e < 8; ++e) { run0 += bflo(rg[e]); run1 += bfhi(rg[e]); G0[e] = run0; G1[e] = run1; }
            *(LAS f32x2_t*)(TOT + part * 128 + 2 * dp) = (f32x2_t){run0, run1};
            __syncthreads();
            float off0 = 0.f, off1 = 0.f, gl0 = 0.f, gl1 = 0.f;
#pragma unroll
            for (int p = 0; p < 8; ++p) { const f32x2_t t = *(const LAS f32x2_t*)(TOT + p * 128 + 2 * dp); gl0 += t.x; gl1 += t.y; if (p < part) { off0 += t.x; off1 += t.y; } }
            const float dec0 = __expf(gl0), dec1 = __expf(gl1);
            if (part == 0) { *(LAS f32x2_t*)(DEC + 2 * dp) = (f32x2_t){dec0, dec1}; segdec0 *= dec0; segdec1 *= dec1; }
            { float kgA[8], kgB[8];
#pragma unroll
              for (int e = 0; e < 8; ++e) {
                  const float eg0 = __expf(G0[e] + off0), eg1 = __expf(G1[e] + off1), ie0 = __builtin_amdgcn_rcpf(eg0), ie1 = __builtin_amdgcn_rcpf(eg1);
                  const float kr0 = bflo(rk[e]) * ie0, kr1 = bfhi(rk[e]) * ie1; kgA[e] = kr0 * dec0; kgB[e] = kr1 * dec1;
                  if (PASS == 2) { *(LAS unsigned*)(QG + (8 * part + e) * 272 + dp * 4) = pg8::cvt_pk_bf16(bflo(rq[e]) * eg0, bfhi(rq[e]) * eg1);
                                   *(LAS unsigned*)(KR + (8 * part + e) * 272 + dp * 4) = pg8::cvt_pk_bf16(kr0, kr1); } }
              u32x4 wa, wb; wa.x = pg8::cvt_pk_bf16(kgA[0], kgA[1]); wa.y = pg8::cvt_pk_bf16(kgA[2], kgA[3]); wa.z = pg8::cvt_pk_bf16(kgA[4], kgA[5]); wa.w = pg8::cvt_pk_bf16(kgA[6], kgA[7]);
              wb.x = pg8::cvt_pk_bf16(kgB[0], kgB[1]); wb.y = pg8::cvt_pk_bf16(kgB[2], kgB[3]); wb.z = pg8::cvt_pk_bf16(kgB[4], kgB[5]); wb.w = pg8::cvt_pk_bf16(kgB[6], kgB[7]);
              *(LAS u32x4*)(KGT + (2 * dp) * 144 + part * 16) = wa; *(LAS u32x4*)(KGT + (2 * dp + 1) * 144 + part * 16) = wb; }
            { const u32x4 va0 = rv[0], va1 = rv[1], vb0 = rv[2], vb1 = rv[3];
              const unsigned av[8] = {va0.x, va0.y, va0.z, va0.w, va1.x, va1.y, va1.z, va1.w}, bv[8] = {vb0.x, vb0.y, vb0.z, vb0.w, vb1.x, vb1.y, vb1.z, vb1.w};
              LAS unsigned char* vp = VT + (16 * cgp) * 144 + tp * 4;
#pragma unroll
              for (int m = 0; m < 8; ++m) { *(LAS unsigned*)(vp + (2 * m) * 144) = (av[m] & 0xffffu) | (bv[m] << 16); *(LAS unsigned*)(vp + (2 * m + 1) * 144) = (av[m] >> 16) | (bv[m] & 0xffff0000u); } }
            __syncthreads();
            if (c + 1 < 8)
            {
#pragma unroll
                for (int e = 0; e < 8; ++e) { const int p = qub + (64 * (c + 1) + e) * NB * 2; if (PASS == 2) rq[e] = __builtin_amdgcn_raw_buffer_load_b32(rPB, qvo, p, 0); rk[e] = __builtin_amdgcn_raw_buffer_load_b32(rPB, qvo, p + 1024, 0); if (PASS == 2) rg[e] = __builtin_amdgcn_raw_buffer_load_b32(rPB, qvo, p + 6144, 0); }
#pragma unroll
                for (int e = 0; e < 2; ++e) { const int p = vub + (64 * (c + 1) + e) * NB * 2; rv[2 * e] = __builtin_amdgcn_raw_buffer_load_b128(rPB, vvo, p, 0); rv[2 * e + 1] = __builtin_amdgcn_raw_buffer_load_b128(rPB, vvo, p + 16, 0); }
            }
            f32x4 oacc[4][2];
            if (PASS == 2) {
#pragma unroll
                for (int u2 = 0; u2 < 2; ++u2) {
                    const int id = 2 * w + u2, it = id >> 2, jt = id & 3;
                    f32x4 a = {0.f, 0.f, 0.f, 0.f};
                    if (jt <= it) {
#pragma unroll
                        for (int ks = 0; ks < 4; ++ks) {
                            const bf16x8 kf = *(const LAS bf16x8*)(KR + (16 * jt + lr) * 272 + (32 * ks + 8 * lq) * 2);
                            const bf16x8 qf = *(const LAS bf16x8*)(QG + (16 * it + lr) * 272 + (32 * ks + 8 * lq) * 2);
                            a = mfma16(kf, qf, a);
                        }
                        if (jt == it) {
#pragma unroll
                            for (int r = 0; r < 4; ++r) if (4 * lq + r > lr) a[r] = 0.f; }
                    }
                    u32x2 pk; pk.x = pg8::cvt_pk_bf16(a[0], a[1]); pk.y = pg8::cvt_pk_bf16(a[2], a[3]);
                    *(LAS u32x2*)(AT + (16 * it + lr) * 144 + (16 * jt + 4 * lq) * 2) = pk;
                }
#pragma unroll
                for (int it = 0; it < 4; ++it) { oacc[it][0] = (f32x4){0.f, 0.f, 0.f, 0.f}; oacc[it][1] = (f32x4){0.f, 0.f, 0.f, 0.f}; }
#pragma unroll
                for (int ks = 0; ks < 4; ++ks) {
                    bf16x8 sf[2];
#pragma unroll
                    for (int vt = 0; vt < 2; ++vt) { u32x4 t; t.x = pg8::cvt_pk_bf16(st[2 * ks][vt][0], st[2 * ks][vt][1]); t.y = pg8::cvt_pk_bf16(st[2 * ks][vt][2], st[2 * ks][vt][3]);
                        t.z = pg8::cvt_pk_bf16(st[2 * ks + 1][vt][0], st[2 * ks + 1][vt][1]); t.w = pg8::cvt_pk_bf16(st[2 * ks + 1][vt][2], st[2 * ks + 1][vt][3]); sf[vt] = __builtin_bit_cast(bf16x8, t); }
#pragma unroll
                    for (int it = 0; it < 4; ++it) {
                        const LAS unsigned char* qp = QG + (16 * it + lr) * 272 + (32 * ks + 4 * lq) * 2;
                        const bf16x4 qa = *(const LAS bf16x4*)qp, qb = *(const LAS bf16x4*)(qp + 32);
                        const bf16x8 qf = __builtin_shufflevector(qa, qb, 0, 1, 2, 3, 4, 5, 6, 7);
                        oacc[it][0] = mfma16(sf[0], qf, oacc[it][0]); oacc[it][1] = mfma16(sf[1], qf, oacc[it][1]);
                    }
                }
                __syncthreads();
            }
            u32x2 er[4][2], ey[4][2];
            __builtin_amdgcn_sched_barrier(0);
            if (PASS == 2) {
#pragma unroll
                for (int it = 0; it < 4; ++it)
#pragma unroll
                    for (int vt = 0; vt < 2; ++vt) { const size_t tku = tb + 64 * c + 16 * it; const int colu = h * 256 + 32 * w + 16 * vt;
                        const int pu = (int)((tku * NB + 2048 + colu) * 2), mu = (int)((tku * D + colu) * 2);
                        er[it][vt] = __builtin_amdgcn_raw_buffer_load_b64(rPB, evo, pu, 0); ey[it][vt] = __builtin_amdgcn_raw_buffer_load_b64(rMR, mvo, mu, 0); }
            }
            bf16x8 vf[2][2];
#pragma unroll
            for (int vt = 0; vt < 2; ++vt)
#pragma unroll
                for (int ks = 0; ks < 2; ++ks) vf[vt][ks] = *(const LAS bf16x8*)(VT + (32 * w + 16 * vt + lr) * 144 + (32 * ks + 8 * lq) * 2);
            if (PASS == 2) {
#pragma unroll
                for (int it = 0; it < 4; ++it)
#pragma unroll
                    for (int ks = 0; ks < 2; ++ks) { if (ks == 1 && it < 2) continue;
                        const bf16x8 af = *(const LAS bf16x8*)(AT + (16 * it + lr) * 144 + (32 * ks + 8 * lq) * 2);
                        oacc[it][0] = mfma16(vf[0][ks], af, oacc[it][0]); oacc[it][1] = mfma16(vf[1][ks], af, oacc[it][1]); }
            }
            u32x2 opk[4][2];
            if (PASS == 2) {
#pragma unroll
                for (int it = 0; it < 4; ++it) { float s = 0.f;
#pragma unroll
                    for (int vt = 0; vt < 2; ++vt)
#pragma unroll
                        for (int r = 0; r < 4; ++r) s += oacc[it][vt][r] * oacc[it][vt][r];
                    s += __shfl_xor(s, 16); s += __shfl_xor(s, 32);
                    if (lq == 0) RED[w * 64 + 16 * it + lr] = s; }
#pragma unroll
                for (int it = 0; it < 4; ++it)
#pragma unroll
                    for (int vt = 0; vt < 2; ++vt) { opk[it][vt].x = pg8::cvt_pk_bf16(oacc[it][vt][0], oacc[it][vt][1]); opk[it][vt].y = pg8::cvt_pk_bf16(oacc[it][vt][2], oacc[it][vt][3]); }
            }
            __builtin_amdgcn_sched_barrier(0);
#pragma unroll
            for (int dt = 0; dt < 8; ++dt) {
                const f32x4 dc = *(const LAS f32x4*)(DEC + 16 * dt + 4 * lq);
                st[dt][0] = st[dt][0] * dc; st[dt][1] = st[dt][1] * dc;
#pragma unroll
                for (int ks = 0; ks < 2; ++ks) { const bf16x8 kf = *(const LAS bf16x8*)(KGT + (16 * dt + lr) * 144 + (32 * ks + 8 * lq) * 2);
                    st[dt][0] = mfma16(kf, vf[0][ks], st[dt][0]); st[dt][1] = mfma16(kf, vf[1][ks], st[dt][1]); }
            }
            __builtin_amdgcn_sched_barrier(0);
            if (PASS == 2) {
                __syncthreads();
#pragma unroll
                for (int half = 0; half < 2; ++half) {
#pragma unroll
                    for (int it2 = 0; it2 < 2; ++it2) { const int it = 2 * half + it2; float ss = 0.f;
#pragma unroll
                        for (int ww = 0; ww < 8; ++ww) ss += RED[ww * 64 + 16 * it + lr];
                        const float rstd = 1.0f / sqrtf(ss * (1.f / 256.f) + EPS);
#pragma unroll
                        for (int vt = 0; vt < 2; ++vt) { const size_t tku = tb + 64 * c + 16 * it; const int colu = h * 256 + 32 * w + 16 * vt;
                            const f32x4 gnv = *(const f32x4*)(gn + 32 * w + 16 * vt + 4 * lq);
                            const f32x4 ou = {bflo(opk[it][vt].x), bfhi(opk[it][vt].x), bflo(opk[it][vt].y), bfhi(opk[it][vt].y)};
                            const f32x4 o = ou * rstd * gnv;
                            const float y0 = bflo(ey[it][vt].x) + o[0] * bflo(er[it][vt].x), y1 = bfhi(ey[it][vt].x) + o[1] * bfhi(er[it][vt].x);
                            const float y2 = bflo(ey[it][vt].y) + o[2] * bflo(er[it][vt].y), y3 = bfhi(ey[it][vt].y) + o[3] * bfhi(er[it][vt].y);
                            u32x2 ow; ow.x = pg8::cvt_pk_bf16(y0, y1); ow.y = pg8::cvt_pk_bf16(y2, y3);
                            __builtin_amdgcn_raw_buffer_store_b64(ow, rMO, mvo, (int)((tku * D + colu) * 2), 0); } }
                }
            }
        }
        if (PASS == 1) {
            const int slu = ((bh * 8 + seg) * 8 + w) * 64 * 256; const unsigned slo = (unsigned)lane * 4u;
#pragma unroll
            for (int dt = 0; dt < 8; ++dt)
#pragma unroll
                for (int vt = 0; vt < 2; ++vt)
#pragma unroll
                    for (int r = 0; r < 4; ++r) __builtin_amdgcn_raw_buffer_store_b32(__float_as_uint(st[dt][vt][r]), rSL, slo, slu + ((dt * 2 + vt) * 4 + r) * 256, 0);
            if (part == 0) { DSEG[(size_t)(bh * 8 + seg) * 128 + 2 * dp] = segdec0; DSEG[(size_t)(bh * 8 + seg) * 128 + 2 * dp + 1] = segdec1; }
        }
    }
}

typedef __attribute__((address_space(1))) unsigned gu32;
#define XB_TMO      128
#define XB_XCNT(j)  (256  + 64 * (j))
#define XB_XSUB(j)  (1280 + 64 * (j))
#define XB_XGEN(j)  (2304 + 64 * (j))
#define XB_TOP      3328
#define XB_TOPGEN   3392
#define XCD_BAR_WORDS 3456
#define XB_SPIN_CAP (1u << 22)

__device__ __forceinline__ unsigned xb_ld(unsigned* p)              { return __hip_atomic_load(p, __ATOMIC_RELAXED, __HIP_MEMORY_SCOPE_AGENT); }
__device__ __forceinline__ unsigned xb_add(unsigned* p, unsigned v) { return __hip_atomic_fetch_add(p, v, __ATOMIC_RELAXED, __HIP_MEMORY_SCOPE_AGENT); }
__device__ __forceinline__ unsigned xb_xcc_id() { return (unsigned)__builtin_amdgcn_s_getreg((3 << 11) | 20) & 0xFu; }
#define XB_SPIN(cond, bar) do { unsigned _sp = 0; while (cond) { __builtin_amdgcn_s_sleep(1); \
    if ((++_sp & 255u) == 0u) { if (xb_ld(&(bar)[XB_TMO])) break; if (_sp > XB_SPIN_CAP) { atomicAdd(&(bar)[XB_TMO], 1u); break; } } } } while (0)

struct XcdBarrier {
    unsigned* bar; unsigned x;
    volatile LAS unsigned* st;
};

__device__ __forceinline__ XcdBarrier xcd_barrier_post(unsigned* bar, volatile LAS unsigned* st) {
    XcdBarrier b; b.bar = bar; b.x = xb_xcc_id(); b.st = st;
    if (threadIdx.x == 0) (void)xb_add(&bar[XB_XCNT(b.x)], 1u);
    return b;
}
__device__ __forceinline__ void xcd_barrier_complete(unsigned* bar, unsigned x, unsigned& nloc, unsigned& nx) {
    const unsigned G = gridDim.x * gridDim.y * gridDim.z;
    unsigned sum, cnt, mine, sp = 0u;
    for (;;) {
        sum = 0u; cnt = 0u; mine = 0u;
#pragma unroll
        for (unsigned j = 0; j < 16; ++j) { const unsigned c = xb_ld(&bar[XB_XCNT(j)]); sum += c; cnt += (c > 0u) ? 1u : 0u; mine = (j == x) ? c : mine; }
        if (sum == G) break;
        __builtin_amdgcn_s_sleep(1);
        if ((++sp & 255u) == 0u) { if (xb_ld(&bar[XB_TMO])) break; if (sp > XB_SPIN_CAP) { atomicAdd(&bar[XB_TMO], 1u); break; } }
    }
    nloc = mine > 0u ? mine : 1u; nx = cnt > 0u ? cnt : 1u;
}

__device__ __forceinline__ void xcd_barrier(const XcdBarrier& b) {
    asm volatile("s_waitcnt vmcnt(0)" ::: "memory");
    __syncthreads();
    if (threadIdx.x == 0) {
        unsigned* bar = b.bar;
        __builtin_amdgcn_s_waitcnt(0);
        unsigned nloc = b.st[0], nx = b.st[1];
        if (nloc == 0u) { xcd_barrier_complete(bar, b.x, nloc, nx); b.st[0] = nloc; b.st[1] = nx; }
        const unsigned old = xb_add(&bar[XB_XSUB(b.x)], 1u);
        const unsigned gen = old / nloc;
        if (old + 1u == (gen + 1u) * nloc) {
            __builtin_amdgcn_fence(__ATOMIC_RELEASE, "agent");
            asm volatile("s_waitcnt vmcnt(0)" ::: "memory");
            const unsigned og = xb_add(&bar[XB_TOP], 1u);
            const unsigned tg = og / nx;
            if (og + 1u == (tg + 1u) * nx) xb_add(&bar[XB_TOPGEN], 1u);
            else XB_SPIN(xb_ld(&bar[XB_TOPGEN]) == tg, bar);
            __builtin_amdgcn_fence(__ATOMIC_ACQUIRE, "agent");
            xb_add(&bar[XB_XGEN(b.x)], 1u);
            asm volatile("s_waitcnt vmcnt(0)" ::: "memory");
        } else {
            XB_SPIN(xb_ld(&bar[XB_XGEN(b.x)]) == gen, bar);
            __builtin_amdgcn_fence(__ATOMIC_ACQUIRE, "agent");
            asm volatile("s_waitcnt vmcnt(0)" ::: "memory");
        }
    }
    __syncthreads();
}

struct Args { const float* in[18]; float* out; unsigned char* ws; int ph_lo, ph_hi; };
constexpr int PH_PER_LAYER = 14;
constexpr int NPH = 2 * PH_PER_LAYER + 1;

__global__ void __launch_bounds__(512, 2) mega_fwd(Args a) {
    extern __shared__ __attribute__((aligned(16))) unsigned char lds_raw[];
    LAS unsigned char* lds = (LAS unsigned char*)lds_raw;
    cg::grid_group grid = cg::this_grid();
    volatile LAS unsigned* MISC = (volatile LAS unsigned*)(lds + LDS_BYTES - 512);
    if (threadIdx.x < 32) MISC[threadIdx.x] = 0u;
    __syncthreads();
    XcdBarrier bar = xcd_barrier_post((unsigned*)(a.ws + WS_CTL) + 4096, MISC + 8);
    grid.sync();
    const int G = gridDim.x, bx = blockIdx.x;
    const int vwg = (G % 8 == 0) ? (bx % 8) * (G / 8) + bx / 8 : bx;
    unsigned char* ws = a.ws;
    float* MOD = (float*)(ws + WS_MOD);
    bf16_t* H = (bf16_t*)(ws + WS_H); bf16_t* MRG = (bf16_t*)(ws + WS_MRG); bf16_t* PROJ = (bf16_t*)(ws + WS_PROJ);
    float* X = a.out;
    for (int ph0 = a.ph_lo; ph0 < a.ph_hi; ++ph0) {
        const int ph = ph0;
        if (ph == NPH - 1) { final_norm_phase(X, H, a.in[17], vwg, G); }
        else {
            const int l = ph / PH_PER_LAYER, p = ph % PH_PER_LAYER;
            const float* modl = MOD + (size_t)l * 8 * NMOD; unsigned char* wsw = ws + WS_W + (size_t)l * WS_WSTRIDE;
            if (p == 0 && l == 1) {   }
            else if (p == 0) {
                if (l == 0) mod_phase(lds, a.in[1], a.in[2], a.in[3], MOD, vwg, G, 0);
                __syncthreads();
                LayerW L; L.f1in = a.in[5] + (size_t)l * D * NFF2; L.f1out = a.in[6] + (size_t)l * FF * D; L.mixin = a.in[8] + (size_t)l * D * INC; L.wgate = a.in[10] + (size_t)l * 16 * 512;
                L.mixout = a.in[13] + (size_t)l * D * D; L.f2in = a.in[15] + (size_t)l * D * NFF2; L.f2out = a.in[16] + (size_t)l * FF * D;
                wconv_phase(lds, L, wsw, vwg, G);
            } else if (p == 1 || p == 4 || p == 11) {
                const int q = (p == 1) ? 0 : (p == 4 ? 1 : 2);
                const float* gain = a.in[q == 0 ? 4 : (q == 1 ? 7 : 14)] + (size_t)l * D;
                const bool from_input = (l == 0 && p <= 4);
                norm_phase(from_input ? a.in[0] : X, X, H, (l == 0 && p == 1) ? 0 : 1, gain, modl + (3 * q) * D, modl + (3 * q + 1) * D, vwg, G);
            } else if (p == 2 || p == 12) {
                pg8::Gemm g{H, (const bf16_t*)(wsw + (p == 2 ? W_1IN : W_2IN)), T, NFF2, D}; pg8::StaticOrder S; S.init(T, NFF2, G, bx);
                EpiSwiGLU E{PROJ};
                pg8::gemm_phase<EpiSwiGLU, pg8::StaticOrder, true, true>(lds, g, S, E);
            } else if (p == 3 || p == 10 || p == 13) {
                const bf16_t* Aop = (p == 10) ? MRG : PROJ; const int K = (p == 10) ? D : FF;
                const bf16_t* Bop = (const bf16_t*)(wsw + (p == 3 ? W_1OUT : (p == 10 ? W_O : W_2OUT)));
                pg8::Gemm g{Aop, Bop, T, D, K}; pg8::StaticOrder S; S.init(T, D, G, bx);
                EpiResid E{H, modl + (p == 3 ? 2 : (p == 10 ? 5 : 8)) * D, p == 10 ? 1.0f : 0.5f};
                pg8::gemm_phase<EpiResid, pg8::StaticOrder, true, true>(lds, g, S, E);
            } else if (p == 5 || p == 7) {
                const int N = (p == 5) ? NAG : NBG;
                pg8::Gemm g{H, (const bf16_t*)(wsw + (p == 5 ? W_A : W_B)), T, N, D}; pg8::StaticOrder S; S.init(T, N, G, bx);
                EpiProj E{PROJ, p == 5 ? NA : NB, p == 5 ? 0 : 1, (float*)(ws + WS_LR)};
                pg8::gemm_phase<EpiProj, pg8::StaticOrder, true, true>(lds, g, S, E);
            } else if (p == 6) {
                LayerW Ln; { const int ln = 1; Ln.f1in = a.in[5] + (size_t)ln * D * NFF2; Ln.f1out = a.in[6] + (size_t)ln * FF * D; Ln.mixin = a.in[8] + (size_t)ln * D * INC; Ln.wgate = a.in[10] + (size_t)ln * 16 * 512;
                    Ln.mixout = a.in[13] + (size_t)ln * D * D; Ln.f2in = a.in[15] + (size_t)ln * D * NFF2; Ln.f2out = a.in[16] + (size_t)ln * FF * D; }
                LayerW Lc; Lc.f1in = a.in[5]; Lc.f1out = a.in[6]; Lc.mixin = a.in[8]; Lc.wgate = a.in[10]; Lc.mixout = a.in[13]; Lc.f2in = a.in[15]; Lc.f2out = a.in[16];
                att_phase(lds, PROJ, MRG, a.in[9] + l * 16, vwg, G, l == 0 ? 1 : 0, Lc, ws + WS_W, Ln, ws + WS_W + WS_WSTRIDE);
            } else if (p == 8) {
                if (l == 0) { mod_phase(lds, a.in[1], a.in[2], a.in[3], MOD, vwg, G, 1); __syncthreads(); }
                gla2_phase<1>(lds, PROJ, MRG, (float*)H, (float*)H + (size_t)8 * 1024 * 1024, a.in[12] + (size_t)l * 256, vwg, G, MRG, (const float*)(ws + WS_LR), a.in[10] + (size_t)l * 16 * 512, a.in[11] + (size_t)l * 512);
            } else if (p == 9) {
                gla2_phase<2>(lds, PROJ, MRG, (float*)H, (float*)H + (size_t)8 * 1024 * 1024, a.in[12] + (size_t)l * 256, vwg, G, MRG, (const float*)(ws + WS_LR), a.in[10] + (size_t)l * 16 * 512, a.in[11] + (size_t)l * 512);
            }
        }
        if (ph == PH_PER_LAYER) continue;
        if (ph0 + 1 < a.ph_hi) xcd_barrier(bar);
    }
}

extern "C" void kernel_launch(void* const* d_in, const int* in_sizes, int n_in, void* d_out, int out_size, void* d_ws, size_t ws_size, hipStream_t stream) {
    static int grid = 0;
    if (grid == 0) {
        int dev = 0, cus = 0, per_cu = 0;
        hipGetDevice(&dev); hipDeviceGetAttribute(&cus, hipDeviceAttributeMultiprocessorCount, dev);
        if (hipFuncSetAttribute((const void*)mega_fwd, hipFuncAttributeMaxDynamicSharedMemorySize, LDS_BYTES) != hipSuccess) fprintf(stderr, "hipFuncSetAttribute failed\n");
        if (hipOccupancyMaxActiveBlocksPerMultiprocessor(&per_cu, (const void*)mega_fwd, 512, LDS_BYTES) != hipSuccess || per_cu < 1) per_cu = 1;
        (void)hipGetLastError();
        grid = cus * 1;
        if (ws_size < 512 * MiB) fprintf(stderr, "kernel_launch: workspace %zu smaller than expected\n", ws_size);
    }
    (void)hipMemsetAsync((char*)d_ws + WS_CTL, 0, CTL_BYTES, stream);
    Args a{};
    for (int i = 0; i < 18; ++i) a.in[i] = (const float*)d_in[i];
    a.out = (float*)d_out; a.ws = (unsigned char*)d_ws;
    a.ph_lo = 0; a.ph_hi = NPH;
    void* args[] = {&a};
    hipError_t e = hipLaunchCooperativeKernel((const void*)mega_fwd, dim3(grid), dim3(512), args, LDS_BYTES, stream);
    if (e != hipSuccess) fprintf(stderr, "cooperative launch failed: %s (grid %d)\n", hipGetErrorString(e), grid);
}
```

```cpp
#include <hip/hip_runtime.h>
#include <hip/hip_cooperative_groups.h>
#include <cstdio>
#include <cstdint>
namespace cg = cooperative_groups;
namespace pg8 {
#define PG8_LAS __attribute__((address_space(3)))
typedef unsigned short bf16_t;
typedef short bf16x8 __attribute__((ext_vector_type(8)));
typedef float f32x4 __attribute__((ext_vector_type(4)));
typedef unsigned u32x4 __attribute__((ext_vector_type(4)));
constexpr int BM = 256, BK = 64, HALF = 128, HTB = HALF * BK * 2  , STAGE_BYTES = 8 * HTB, NXCD = 8, WGM = 8;

__host__ __device__ __forceinline__ int lds_byte(int r, int c) { const int st = (r >> 4) * 2 + (c >> 5), rr = r & 15, cc = c & 31, ob = rr * 64 + cc * 2; return st * 1024 + (ob ^ (((ob >> 9) & 1) << 5)); }
__host__ __device__ __forceinline__ void stage_rc(int b, int& R, int& C) { const int st = b / 1024, sb = b % 1024, swz = sb ^ (((sb >> 9) & 1) << 5); R = (st >> 1) * 16 + swz / 64; C = (st & 1) * 32 + (swz % 64) / 2; }
__host__ __device__ __forceinline__ int perm32(int rho) { const int n = rho >> 4, i = rho & 15; return 8 * (i >> 2) + 4 * n + (i & 3); }

struct Unit { int pm, pn; };
struct Gemm { const bf16_t* A; const bf16_t* Bt; int M, N, K; };

struct StaticOrder {
    int nM, nN, nwg, G, c;
    __host__ __device__ void init(int M, int N, int G_, int c_) { nM = M / BM; nN = N / BM; nwg = nM * nN; G = G_; c = c_; }
    __host__ __device__ bool next(int i, Unit& u) const {
        const long L = (long)i * G + c; if (L >= nwg) return false;
        int wgid = (int)L; { const int q = nwg / NXCD, r = nwg % NXCD, xcd = wgid % NXCD, off = wgid / NXCD; wgid = (xcd < r ? xcd * (q + 1) : r * (q + 1) + (xcd - r) * q) + off; }
        const int nig = WGM * nN, gid = wgid / nig, fm = gid * WGM, gsz = (nM - fm) < WGM ? (nM - fm) : WGM;
        u.pm = fm + ((wgid % nig) % gsz); u.pn = (wgid % nig) / gsz; return true;
    }
    __device__ __forceinline__ void a_ready(const Unit&) const {}
    __device__ __forceinline__ void done(const Unit&) const {}
};
__device__ __forceinline__ unsigned cvt_pk_bf16(float lo, float hi) { typedef float f2_ __attribute__((ext_vector_type(2))); typedef __bf16 b2_ __attribute__((ext_vector_type(2)));
    f2_ v = {lo, hi}; b2_ r = __builtin_convertvector(v, b2_); return __builtin_bit_cast(unsigned, r); }
template <class Epi, class Sched, bool ALIGN_EPI = false, bool SP2 = false>
__device__ __forceinline__ void gemm_phase(PG8_LAS unsigned char* lds, const Gemm g, const Sched& S, const Epi& E) {
    int tid_o = threadIdx.x; asm volatile("" : "+v"(tid_o));
    const int tid = tid_o, wid = __builtin_amdgcn_readfirstlane(tid >> 6), lane = tid & 63, wr = wid >> 2, wc = wid & 3, fr = lane & 15, fq = lane >> 4;
    const int K = g.K, nt = K / BK;
    unsigned voffA[2], voffB[2];
#pragma unroll
    for (int i = 0; i < 2; ++i) { int R, C; stage_rc(tid * 16 + i * 8192, R, C); const int Rb = Epi::PERM ? ((R & ~31) + perm32(R & 31)) : R;
        voffA[i] = (unsigned)(R * K + C) * 2u; voffB[i] = (unsigned)(Rb * K + C) * 2u; }
    const size_t kstep = (size_t)(BK * 2);
    const size_t hstep = (size_t)HALF * K * 2;
    const size_t tstep = 2 * hstep;
    const unsigned ldsw = (unsigned)wid * 1024u;
    const int aoff = lds_byte(wr * 64 + fr, fq * 8), boff = lds_byte(wc * 32 + fr, fq * 8);
#define PG8_SA(b, h) (((b) * 2 + (h)) * HTB)
#define PG8_SB(b, h) ((4 + (b) * 2 + (h)) * HTB)
#define PG8_STAGE(bufoff, gbase, voff) do { _Pragma("unroll") for (int _i = 0; _i < 2; ++_i) \
        __builtin_amdgcn_global_load_lds((const unsigned*)((const char*)(gbase) + (voff)[_i]), (PG8_LAS unsigned*)(lds + (bufoff) + ldsw + _i * 8192), 16, 0, 0); } while (0)
#define PG8_LDA(dst, b, h) do { _Pragma("unroll") for (int m = 0; m < 4; ++m) _Pragma("unroll") for (int k = 0; k < 2; ++k) dst[m][k] = *(const PG8_LAS bf16x8*)(lds + PG8_SA(b, h) + aoff + m * 2048 + k * 1024); } while (0)
#define PG8_LDB(dst, b, h) do { _Pragma("unroll") for (int n = 0; n < 2; ++n) _Pragma("unroll") for (int k = 0; k < 2; ++k) dst[n][k] = *(const PG8_LAS bf16x8*)(lds + PG8_SB(b, h) + boff + n * 2048 + k * 1024); } while (0)
#define PG8_MMA(ai, bj, At, Bt) do { __builtin_amdgcn_s_setprio(1); _Pragma("unroll") for (int m = 0; m < 4; ++m) _Pragma("unroll") for (int n = 0; n < 2; ++n) _Pragma("unroll") for (int k = 0; k < 2; ++k) \
        acc[ai][bj][m][n] = __builtin_amdgcn_mfma_f32_16x16x32_bf16(Bt[n][k], At[m][k], acc[ai][bj][m][n], 0, 0, 0); __builtin_amdgcn_s_setprio(0); } while (0)
#define PG8_WAIT_V(n) asm volatile("s_waitcnt vmcnt(" #n ")" ::: "memory")
#define PG8_WAIT_L(n) asm volatile("s_waitcnt lgkmcnt(" #n ")" ::: "memory")
#define PG8_BAR __builtin_amdgcn_s_barrier()
#define PG8_SCHED __builtin_amdgcn_sched_barrier(0)
    Unit cur, nxt; int ui = 0;
    if (!S.next(0, cur)) return;
    f32x4 acc[2][2][4][2];
#pragma unroll
    for (int a = 0; a < 2; ++a)
#pragma unroll
        for (int b = 0; b < 2; ++b)
#pragma unroll
            for (int m = 0; m < 4; ++m)
#pragma unroll
                for (int n = 0; n < 2; ++n) acc[a][b][m][n] = (f32x4){0.f, 0.f, 0.f, 0.f};
    bf16x8 At[4][2], B0[2][2], B1[2][2];
    const char* cA = (const char*)g.A + (size_t)cur.pm * tstep; const char* cB = (const char*)g.Bt + (size_t)cur.pn * tstep;
    S.a_ready(cur);
    if constexpr (SP2) {
        PG8_STAGE(PG8_SB(0, 0), cB, voffB); PG8_STAGE(PG8_SB(0, 1), cB + hstep, voffB); PG8_STAGE(PG8_SA(0, 0), cA, voffA); PG8_STAGE(PG8_SA(0, 1), cA + hstep, voffA);
        if (wr == 1) PG8_BAR;
        PG8_WAIT_V(2); PG8_BAR;
        PG8_STAGE(PG8_SB(1, 0), cB + kstep, voffB); PG8_STAGE(PG8_SA(1, 0), cA + kstep, voffA); PG8_STAGE(PG8_SB(1, 1), cB + hstep + kstep, voffB);
        PG8_WAIT_V(6); PG8_BAR;
    } else {
        PG8_STAGE(PG8_SB(0, 0), cB, voffB); PG8_STAGE(PG8_SA(0, 0), cA, voffA); PG8_STAGE(PG8_SB(0, 1), cB + hstep, voffB); PG8_STAGE(PG8_SA(0, 1), cA + hstep, voffA);
        if (wr == 1) PG8_BAR;
        PG8_WAIT_V(4); PG8_BAR;
        PG8_STAGE(PG8_SB(1, 0), cB + kstep, voffB); PG8_STAGE(PG8_SA(1, 0), cA + kstep, voffA); PG8_STAGE(PG8_SB(1, 1), cB + hstep + kstep, voffB);
        PG8_WAIT_V(6); PG8_BAR;
    }
    for (;;) {
        const bool has_next = S.next(ui + 1, nxt);
        const char* nA = has_next ? (const char*)g.A + (size_t)nxt.pm * tstep : cA; const char* nB = has_next ? (const char*)g.Bt + (size_t)nxt.pn * tstep : cB;
        for (int t = 0; t < nt; t += 2) {
            const bool last = (t == nt - 2);
            const char* a1 = cA + (size_t)(t + 1) * kstep;
            const char* a2 = last ? nA : cA + (size_t)(t + 2) * kstep; const char* b2 = last ? nB : cB + (size_t)(t + 2) * kstep;
            const char* a3 = a2 + kstep; const char* b3 = b2 + kstep;
            if (last && has_next) S.a_ready(nxt);
            if constexpr (SP2) {
            PG8_LDB(B0, 0, 0); PG8_LDB(B1, 0, 1); PG8_SCHED; PG8_LDA(At, 0, 0); PG8_STAGE(PG8_SA(1, 1), a1 + hstep, voffA);
            PG8_WAIT_V(8); PG8_WAIT_L(0); PG8_BAR; PG8_MMA(0, 0, At, B0); PG8_MMA(0, 1, At, B1); PG8_BAR; PG8_SCHED;
            PG8_LDA(At, 0, 1); PG8_STAGE(PG8_SB(0, 0), b2, voffB); PG8_STAGE(PG8_SB(0, 1), b2 + hstep, voffB); PG8_STAGE(PG8_SA(0, 0), a2, voffA);
            PG8_WAIT_V(8); PG8_WAIT_L(0); PG8_BAR; PG8_MMA(1, 0, At, B0); PG8_MMA(1, 1, At, B1); PG8_BAR; PG8_SCHED;
            PG8_LDB(B0, 1, 0); PG8_LDB(B1, 1, 1); PG8_SCHED; PG8_LDA(At, 1, 0); PG8_STAGE(PG8_SA(0, 1), a2 + hstep, voffA);
            PG8_WAIT_V(8); PG8_WAIT_L(0); PG8_BAR; PG8_MMA(0, 0, At, B0); PG8_MMA(0, 1, At, B1); PG8_BAR; PG8_SCHED;
            PG8_LDA(At, 1, 1); PG8_STAGE(PG8_SB(1, 0), b3, voffB); PG8_STAGE(PG8_SB(1, 1), b3 + hstep, voffB); PG8_STAGE(PG8_SA(1, 0), a3, voffA);
            PG8_WAIT_V(8); PG8_WAIT_L(0); PG8_BAR; PG8_MMA(1, 0, At, B0); PG8_MMA(1, 1, At, B1); PG8_BAR; PG8_SCHED;
            } else {
            PG8_LDB(B0, 0, 0); PG8_SCHED; PG8_LDA(At, 0, 0); PG8_STAGE(PG8_SA(1, 1), a1 + hstep, voffA);
            PG8_WAIT_L(8); PG8_BAR; PG8_WAIT_L(0); PG8_MMA(0, 0, At, B0); PG8_BAR; PG8_SCHED;
            PG8_LDB(B1, 0, 1); PG8_STAGE(PG8_SB(0, 0), b2, voffB);
            PG8_BAR; PG8_WAIT_L(0); PG8_MMA(0, 1, At, B1); PG8_BAR;
            PG8_LDA(At, 0, 1); PG8_STAGE(PG8_SA(0, 0), a2, voffA);
            PG8_BAR; PG8_WAIT_L(0); PG8_MMA(1, 0, At, B0); PG8_BAR; PG8_SCHED;
            PG8_STAGE(PG8_SB(0, 1), b2 + hstep, voffB);
            PG8_WAIT_V(6); PG8_BAR; PG8_MMA(1, 1, At, B1); PG8_BAR;
            PG8_LDB(B0, 1, 0); PG8_SCHED; PG8_LDA(At, 1, 0); PG8_STAGE(PG8_SA(0, 1), a2 + hstep, voffA);
            PG8_WAIT_L(8); PG8_BAR; PG8_WAIT_L(0); PG8_MMA(0, 0, At, B0); PG8_BAR; PG8_SCHED;
            PG8_LDB(B1, 1, 1); PG8_STAGE(PG8_SB(1, 0), b3, voffB);
            PG8_BAR; PG8_WAIT_L(0); PG8_MMA(0, 1, At, B1); PG8_BAR;
            PG8_LDA(At, 1, 1); PG8_STAGE(PG8_SA(1, 0), a3, voffA);
            PG8_BAR; PG8_WAIT_L(0); PG8_MMA(1, 0, At, B0); PG8_BAR; PG8_SCHED;
            PG8_STAGE(PG8_SB(1, 1), b3 + hstep, voffB);
            PG8_WAIT_V(6); PG8_BAR; PG8_MMA(1, 1, At, B1); PG8_BAR;
            }
        }
        if constexpr (ALIGN_EPI) { if (wr == 0) PG8_BAR; }
        if constexpr (!Epi::AFTER_DRAIN) { E(acc, cur, wr, wc, fr, fq); S.done(cur); }
        if (!has_next) break;
#pragma unroll
        for (int a = 0; a < 2; ++a)
#pragma unroll
            for (int b = 0; b < 2; ++b)
#pragma unroll
                for (int m = 0; m < 4; ++m)
#pragma unroll
                    for (int n = 0; n < 2; ++n) acc[a][b][m][n] = (f32x4){0.f, 0.f, 0.f, 0.f};
        cur = nxt; cA = nA; cB = nB; ++ui;
        if constexpr (ALIGN_EPI) { if (wr == 1) PG8_BAR; }
    }
    PG8_WAIT_V(0);
    if constexpr (!ALIGN_EPI) { if (wr == 0) PG8_BAR; }
    PG8_BAR;
    if constexpr (Epi::AFTER_DRAIN) { E.fused(acc, cur, wr, wc, fr, fq, lds, wid, lane); S.done(cur); }
#undef PG8_SA
#undef PG8_SB
#undef PG8_STAGE
#undef PG8_LDA
#undef PG8_LDB
#undef PG8_MMA
#undef PG8_WAIT_V
#undef PG8_WAIT_L
#undef PG8_BAR
#undef PG8_SCHED
}
}

#define LAS __attribute__((address_space(3)))
typedef unsigned short bf16_t;
typedef short bf16x8 __attribute__((ext_vector_type(8)));
typedef short bf16x4 __attribute__((ext_vector_type(4)));
typedef float f32x4 __attribute__((ext_vector_type(4)));
typedef unsigned u32x4 __attribute__((ext_vector_type(4)));
typedef unsigned u32x2 __attribute__((ext_vector_type(2)));
typedef float f32x2_t __attribute__((ext_vector_type(2)));
constexpr int T = 32768, D = 1024, FF = 2816, NFF2 = 5632, SEQ = 4096, NMOD = 9216, INC = 6416;
constexpr int NA = 2304, NAG = 2560, NBG = 4096, NB = 3584;
constexpr float EPS = 1e-6f;
constexpr size_t MiB = 1u << 20;
constexpr size_t WS_CTL = 0, CTL_BYTES = 65536;
constexpr size_t WS_MOD = 65536;
constexpr size_t WS_W = 1 * MiB, WS_WSTRIDE = 49 * MiB;
constexpr size_t W_1IN = 0, W_1OUT = W_1IN + (size_t)NFF2 * D * 2, W_A = W_1OUT + (size_t)D * FF * 2, W_B = W_A + (size_t)NAG * D * 2,
                 W_O = W_B + (size_t)NBG * D * 2, W_2IN = W_O + (size_t)D * D * 2, W_2OUT = W_2IN + (size_t)NFF2 * D * 2, W_END = W_2OUT + (size_t)D * FF * 2;
static_assert(W_END <= 49 * MiB, "weights");
constexpr size_t WS_H = 99 * MiB;
constexpr size_t WS_MRG = 163 * MiB;
constexpr size_t WS_PROJ = 227 * MiB;
static_assert((size_t)T * NB * 2 <= 224 * MiB && (size_t)T * FF * 2 <= 224 * MiB && (size_t)T * NA * 2 <= 224 * MiB, "PROJ region = 224 MiB");
constexpr size_t WS_LR = 451 * MiB;
constexpr int LDS_BYTES = 147456;

__device__ __forceinline__ float bf2f(unsigned v) { return __uint_as_float(v << 16); }
__device__ __forceinline__ float bflo(unsigned v) { return __uint_as_float(v << 16); }
__device__ __forceinline__ float bfhi(unsigned v) { return __uint_as_float(v & 0xffff0000u); }
__device__ __forceinline__ float wave_sum(float v) {
#pragma unroll
    for (int o = 1; o < 64; o <<= 1) v += __shfl_xor(v, o);
    return v;
}
__device__ __forceinline__ float sigm(float v) { return __builtin_amdgcn_rcpf(1.f + __expf(-v)); }
__device__ __forceinline__ f32x4 mfma16(bf16x8 a, bf16x8 b, f32x4 c) { return __builtin_amdgcn_mfma_f32_16x16x32_bf16(a, b, c, 0, 0, 0); }

__device__ __forceinline__ int otid() { int t = threadIdx.x; asm volatile("" : "+v"(t)); return t; }
using pg8::Unit;
struct EpiSwiGLU {
    static constexpr bool PERM = true, AFTER_DRAIN = false;
    bf16_t* O;
    __device__ __forceinline__ void operator()(const f32x4 (&acc)[2][2][4][2], const Unit& u, int wr, int wc, int fr, int fq) const {
        const int row0 = u.pm * 256 + wr * 64 + fr, col0 = u.pn * 128 + wc * 32 + 8 * fq;
#pragma unroll
        for (int ai = 0; ai < 2; ++ai)
#pragma unroll
            for (int m = 0; m < 4; ++m) {
                bf16_t* rowp = O + (size_t)(row0 + ai * 128 + m * 16) * FF + col0;
                float v[8];
#pragma unroll
                for (int n = 0; n < 2; ++n)
#pragma unroll
                    for (int j = 0; j < 4; ++j) { const float g = acc[ai][0][m][n][j], up = acc[ai][1][m][n][j]; v[n * 4 + j] = g * sigm(g) * up; }
                u32x4 w; w.x = pg8::cvt_pk_bf16(v[0], v[1]); w.y = pg8::cvt_pk_bf16(v[2], v[3]); w.z = pg8::cvt_pk_bf16(v[4], v[5]); w.w = pg8::cvt_pk_bf16(v[6], v[7]);
                *(u32x4*)rowp = w;
            }
    }
};
struct EpiResid {
    static constexpr bool PERM = true, AFTER_DRAIN = false;
    bf16_t* Dl; const float* gate; float coef;
    __device__ __forceinline__ void operator()(const f32x4 (&acc)[2][2][4][2], const Unit& u, int wr, int wc, int fr, int fq) const {
        const int row0 = u.pm * 256 + wr * 64 + fr, b = u.pm >> 4;
#pragma unroll
        for (int bj = 0; bj < 2; ++bj) {
            const int col0 = u.pn * 256 + bj * 128 + wc * 32 + 8 * fq;
            const f32x4 g0 = *(const f32x4*)(gate + (size_t)b * NMOD + col0) * coef, g1 = *(const f32x4*)(gate + (size_t)b * NMOD + col0 + 4) * coef;
#pragma unroll
            for (int ai = 0; ai < 2; ++ai)
#pragma unroll
                for (int m = 0; m < 4; ++m) { const f32x4 v0 = acc[ai][bj][m][0] * g0, v1 = acc[ai][bj][m][1] * g1;
                    u32x4 w; w.x = pg8::cvt_pk_bf16(v0[0], v0[1]); w.y = pg8::cvt_pk_bf16(v0[2], v0[3]); w.z = pg8::cvt_pk_bf16(v1[0], v1[1]); w.w = pg8::cvt_pk_bf16(v1[2], v1[3]);
                    *(u32x4*)(Dl + (size_t)(row0 + ai * 128 + m * 16) * D + col0) = w; }
        }
    }
};
struct EpiProj {
    static constexpr bool PERM = true, AFTER_DRAIN = false;
    bf16_t* O; int ldc; int mode; float* LR;
    __device__ __forceinline__ void operator()(const f32x4 (&acc)[2][2][4][2], const Unit& u, int wr, int wc, int fr, int fq) const {
        const int row0 = u.pm * 256 + wr * 64 + fr;
        if (mode == 0 && u.pn == 9) {
            if (wc == 0 && fq < 2) {
#pragma unroll
                for (int ai = 0; ai < 2; ++ai)
#pragma unroll
                    for (int m = 0; m < 4; ++m) { float* lp = LR + (size_t)(row0 + ai * 128 + m * 16) * 16 + 8 * fq; *(f32x4*)lp = acc[ai][0][m][0]; *(f32x4*)(lp + 4) = acc[ai][0][m][1]; }
            }
            return;
        }
        if (mode == 1 && u.pn >= 8 && u.pn < 16) {
            const int col0 = 2048 + 128 * (u.pn - 8) + wc * 32 + 8 * fq;
#pragma unroll
            for (int ai = 0; ai < 2; ++ai)
#pragma unroll
                for (int m = 0; m < 4; ++m) {
                    float v[8];
#pragma unroll
                    for (int n = 0; n < 2; ++n)
#pragma unroll
                        for (int j = 0; j < 4; ++j) { const float r_ = acc[ai][0][m][n][j], g_ = acc[ai][1][m][n][j]; v[n * 4 + j] = r_ * sigm(r_) * sigm(g_); }
                    u32x4 w; w.x = pg8::cvt_pk_bf16(v[0], v[1]); w.y = pg8::cvt_pk_bf16(v[2], v[3]); w.z = pg8::cvt_pk_bf16(v[4], v[5]); w.w = pg8::cvt_pk_bf16(v[6], v[7]);
                    *(u32x4*)(O + (size_t)(row0 + ai * 128 + m * 16) * ldc + col0) = w;
                }
            return;
        }
#pragma unroll
        for (int bj = 0; bj < 2; ++bj) {
            const int c0 = u.pn * 256 + bj * 128;
            int code, oc0 = c0; float sc = 1.f;
            if (mode == 0) { if (c0 < 1024) { code = 0; sc = 0.125f; } else if (c0 < 1280) code = 0; else code = 1; }
            else { code = 0; if (c0 < 512) sc = 0.08838834764831845f; }
            const int col0 = oc0 + wc * 32 + 8 * fq;
#pragma unroll
            for (int ai = 0; ai < 2; ++ai)
#pragma unroll
                for (int m = 0; m < 4; ++m) {
                    float v[8];
#pragma unroll
                    for (int n = 0; n < 2; ++n)
#pragma unroll
                        for (int j = 0; j < 4; ++j) { float x = acc[ai][bj][m][n][j];
                            if (code == 0) x = x * sc;
                            else x = sigm(x);
                            v[n * 4 + j] = x; }
                    u32x4 w; w.x = pg8::cvt_pk_bf16(v[0], v[1]); w.y = pg8::cvt_pk_bf16(v[2], v[3]); w.z = pg8::cvt_pk_bf16(v[4], v[5]); w.w = pg8::cvt_pk_bf16(v[6], v[7]);
                    *(u32x4*)(O + (size_t)(row0 + ai * 128 + m * 16) * ldc + col0) = w;
                }
        }
    }
};

__device__ __forceinline__ void transpose_item(const float* W, int Nsrc, int K, bf16_t* WT, int k0, int srccol0, int dstrow0, LAS float* scr, int lane) {
#pragma unroll 8
    for (int i = 0; i < 32; ++i) { const int kk = 2 * i + (lane >> 5); scr[kk * 33 + (lane & 31)] = W[(size_t)(k0 + kk) * Nsrc + srccol0 + (lane & 31)]; }
    asm volatile("s_waitcnt lgkmcnt(0)" ::: "memory");
    const int c = lane & 7;
#pragma unroll
    for (int j = 0; j < 4; ++j) { const int n = (lane >> 3) + 8 * j; const LAS float* s = scr + (8 * c) * 33 + n;
        u32x4 o; o.x = pg8::cvt_pk_bf16(s[0 * 33], s[1 * 33]); o.y = pg8::cvt_pk_bf16(s[2 * 33], s[3 * 33]); o.z = pg8::cvt_pk_bf16(s[4 * 33], s[5 * 33]); o.w = pg8::cvt_pk_bf16(s[6 * 33], s[7 * 33]);
        *(u32x4*)(WT + (size_t)(dstrow0 + n) * K + k0 + 8 * c) = o; }
    asm volatile("s_waitcnt lgkmcnt(0)" ::: "memory");
}
__device__ __forceinline__ int map_src(int mapid, int r) {
    if (mapid == 1) { const int pn = r >> 8, bj = (r >> 7) & 1, j = r & 127; return bj * FF + 128 * pn + j; }
    if (mapid == 2) return r < 1280 ? r : (r < 2304 ? r + 3088 : 3328 + (r - 2304));
    if (mapid == 3) { if (r < 2048) return r + 1280; const int rr = r - 2048, t = rr >> 8, bj = (rr >> 7) & 1, j = rr & 127; return (bj ? 5392 : 3344) + 128 * t + j; }
    return r;
}
struct ConvItem { const float* W; bf16_t* WT; int Nsrc, K, k0, srccol0, dstrow0; };
__device__ __forceinline__ void tr_load(const ConvItem& ci, int lane, float (&tv)[32]) {
#pragma unroll
    for (int i = 0; i < 32; ++i) { const int kk = 2 * i + (lane >> 5); tv[i] = ci.W[(size_t)(ci.k0 + kk) * ci.Nsrc + ci.srccol0 + (lane & 31)]; }
}
__device__ __forceinline__ void tr_finish(const ConvItem& ci, int lane, const float (&tv)[32], LAS float* scr) {
#pragma unroll
    for (int i = 0; i < 32; ++i) { const int kk = 2 * i + (lane >> 5); scr[kk * 33 + (lane & 31)] = tv[i]; }
    asm volatile("s_waitcnt lgkmcnt(0)" ::: "memory");
    const int c = lane & 7;
#pragma unroll
    for (int j = 0; j < 4; ++j) { const int n = (lane >> 3) + 8 * j; const LAS float* s = scr + (8 * c) * 33 + n;
        u32x4 o; o.x = pg8::cvt_pk_bf16(s[0 * 33], s[1 * 33]); o.y = pg8::cvt_pk_bf16(s[2 * 33], s[3 * 33]); o.z = pg8::cvt_pk_bf16(s[4 * 33], s[5 * 33]); o.w = pg8::cvt_pk_bf16(s[6 * 33], s[7 * 33]);
        *(u32x4*)(ci.WT + (size_t)(ci.dstrow0 + n) * ci.K + ci.k0 + 8 * c) = o; }
    asm volatile("s_waitcnt lgkmcnt(0)" ::: "memory");
}
__device__ __forceinline__ bool conv_try(int& it, const float* W, int Nsrc, int K, bf16_t* WT, int ndst, int mapid, LAS float* scr, int lane) {
    const int ng = ndst / 32, n = (K / 64) * ng;
    if (it >= n) { it -= n; return false; }
    const int kb = it / ng, g = it % ng;
    transpose_item(W, Nsrc, K, WT, 64 * kb, map_src(mapid, 32 * g), 32 * g, scr, lane);
    return true;
}
struct LayerW { const float *f1in, *f1out, *mixin, *wgate, *mixout, *f2in, *f2out; };
constexpr int CONV_NITEMS = 2 * (16 * 176) + 2 * (44 * 32) + 16 * 80 + 16 * 128 + 16 * 32;
__device__ __forceinline__ bool conv_pick(int& it, const float* W, int Nsrc, int K, bf16_t* WT, int ndst, int mapid, ConvItem& ci) {
    const int ng = ndst / 32, n = (K / 64) * ng;
    if (it >= n) { it -= n; return false; }
    const int kb = it / ng, g = it % ng;
    ci.W = W; ci.WT = WT; ci.Nsrc = Nsrc; ci.K = K; ci.k0 = 64 * kb; ci.srccol0 = map_src(mapid, 32 * g); ci.dstrow0 = 32 * g; return true;
}
constexpr int CONV_LATE = 16 * 128 + 16 * 176 + 44 * 32 + 16 * 32;
__device__ __forceinline__ ConvItem conv_decode_late(int it, const LayerW& L, unsigned char* wsw) {
    ConvItem ci;
    if (conv_pick(it, L.mixin, INC, D, (bf16_t*)(wsw + W_B), 4096, 3, ci)) return ci;
    if (conv_pick(it, L.f2in, NFF2, D, (bf16_t*)(wsw + W_2IN), NFF2, 1, ci)) return ci;
    if (conv_pick(it, L.f2out, D, FF, (bf16_t*)(wsw + W_2OUT), D, 0, ci)) return ci;
    conv_pick(it, L.mixout, D, D, (bf16_t*)(wsw + W_O), D, 0, ci); return ci;
}
__device__ __forceinline__ ConvItem conv_decode(int it, const LayerW& L, unsigned char* wsw) {
    ConvItem ci;
    if (conv_pick(it, L.f1in, NFF2, D, (bf16_t*)(wsw + W_1IN), NFF2, 1, ci)) return ci;
    if (conv_pick(it, L.f2in, NFF2, D, (bf16_t*)(wsw + W_2IN), NFF2, 1, ci)) return ci;
    if (conv_pick(it, L.f1out, D, FF, (bf16_t*)(wsw + W_1OUT), D, 0, ci)) return ci;
    if (conv_pick(it, L.f2out, D, FF, (bf16_t*)(wsw + W_2OUT), D, 0, ci)) return ci;
    if (conv_pick(it, L.mixin, INC, D, (bf16_t*)(wsw + W_A), NAG, 2, ci)) return ci;
    if (conv_pick(it, L.mixin, INC, D, (bf16_t*)(wsw + W_B), 4096, 3, ci)) return ci;
    conv_pick(it, L.mixout, D, D, (bf16_t*)(wsw + W_O), D, 0, ci); return ci;
}
__device__ __forceinline__ void wconv_phase(LAS unsigned char* lds, const LayerW& L, unsigned char* wsw, int vwg, int G) {
    const int tid = otid(), lane = tid & 63, wave = __builtin_amdgcn_readfirstlane(tid >> 6);
    LAS float* scr = (LAS float*)(lds + wave * 8704);
    const int gw = vwg * 8 + wave, NGW = G * 8;
    constexpr int NITEMS = 16 * 176 + 44 * 32 + 16 * 80;
    for (int it0 = gw; it0 < NITEMS; it0 += NGW) {
        int it = it0;
        if (conv_try(it, L.f1in, NFF2, D, (bf16_t*)(wsw + W_1IN), NFF2, 1, scr, lane)) continue;
        if (conv_try(it, L.f1out, D, FF, (bf16_t*)(wsw + W_1OUT), D, 0, scr, lane)) continue;
        conv_try(it, L.mixin, INC, D, (bf16_t*)(wsw + W_A), NAG, 2, scr, lane);
    }
}
__device__ __forceinline__ void mod_phase(LAS unsigned char* lds, const float* c, const float* ada_w, const float* ada_b, float* MOD, int vwg, int G, int l) {
    const int tid = otid(), lane = tid & 63, wave = __builtin_amdgcn_readfirstlane(tid >> 6);
    LAS float* cond = (LAS float*)lds;
    LAS float* red = (LAS float*)(lds + 32768);
    for (int i = tid; i < 8 * D; i += 512) { const float v = c[i]; cond[i] = v * sigm(v); }
    __syncthreads();
    for (int item = vwg; item < NMOD / 64; item += G) {
        const int n0 = item * 64;
        const float* wp = ada_w + (size_t)l * D * NMOD + (size_t)(wave * 128) * NMOD + n0 + lane;
        float acc[8];
#pragma unroll
        for (int b = 0; b < 8; ++b) acc[b] = 0.f;
        for (int k4 = 0; k4 < 32; ++k4) {
            float wv[4];
#pragma unroll
            for (int j = 0; j < 4; ++j) wv[j] = wp[(size_t)(k4 * 4 + j) * NMOD];
#pragma unroll
            for (int b = 0; b < 8; ++b) { const f32x4 cv = *(const LAS f32x4*)(cond + b * D + wave * 128 + k4 * 4); acc[b] += cv[0] * wv[0] + cv[1] * wv[1] + cv[2] * wv[2] + cv[3] * wv[3]; }
        }
#pragma unroll
        for (int b = 0; b < 8; ++b) red[(wave * 8 + b) * 64 + lane] = acc[b];
        __syncthreads();
        { const int b = tid >> 6; float s = ada_b[(size_t)l * NMOD + n0 + lane];
#pragma unroll
          for (int w = 0; w < 8; ++w) s += red[(w * 8 + b) * 64 + lane];
          MOD[((size_t)l * 8 + b) * NMOD + n0 + lane] = s; }
        __syncthreads();
    }
}

__device__ __forceinline__ void norm_phase(const float* Xin, float* Xout, bf16_t* H, int has_delta, const float* gain, const float* shift, const float* scale, int vwg, int G) {
    const int tid_ = otid(), lane = tid_ & 63, wave = __builtin_amdgcn_readfirstlane(tid_ >> 6);
    for (int rg = vwg * 8 + wave; rg < T / 16; rg += G * 8) {
        const int row0 = rg * 16, b = row0 / SEQ;
        f32x4 A[4], Bs[4];
#pragma unroll
        for (int j = 0; j < 4; ++j) { const int cidx = 4 * lane + 256 * j; const f32x4 g = *(const f32x4*)(gain + cidx), sc = *(const f32x4*)(scale + (size_t)b * NMOD + cidx);
            A[j] = g * (sc + 1.0f); Bs[j] = *(const f32x4*)(shift + (size_t)b * NMOD + cidx); }
        for (int r = 0; r < 16; ++r) {
            const f32x4* xr = (const f32x4*)(Xin + (size_t)(row0 + r) * D) + lane;
            u32x2* o8 = (u32x2*)(H + (size_t)(row0 + r) * D) + lane;
            f32x4 v[4]; float s = 0.f;
#pragma unroll
            for (int j = 0; j < 4; ++j) { v[j] = xr[64 * j];
                if (has_delta) { const u32x2 d = o8[64 * j]; v[j] += (f32x4){bflo(d.x), bfhi(d.x), bflo(d.y), bfhi(d.y)}; }
                s += (v[j][0] * v[j][0] + v[j][1] * v[j][1]) + (v[j][2] * v[j][2] + v[j][3] * v[j][3]); }
            if (has_delta) { f32x4* xo = (f32x4*)(Xout + (size_t)(row0 + r) * D) + lane;
#pragma unroll
                for (int j = 0; j < 4; ++j) xo[64 * j] = v[j]; }
            const float rstd = 1.0f / sqrtf(wave_sum(s) * (1.f / D) + EPS);
#pragma unroll
            for (int j = 0; j < 4; ++j) { const f32x4 y = (v[j] * rstd) * A[j] + Bs[j]; u32x2 w; w.x = pg8::cvt_pk_bf16(y[0], y[1]); w.y = pg8::cvt_pk_bf16(y[2], y[3]); o8[64 * j] = w; }
        }
    }
}
__device__ __forceinline__ void final_norm_phase(float* X, const bf16_t* H, const float* gain, int vwg, int G) {
    const int tid_ = otid(), lane = tid_ & 63, wave = __builtin_amdgcn_readfirstlane(tid_ >> 6);
    f32x4 A[4];
#pragma unroll
    for (int j = 0; j < 4; ++j) A[j] = *(const f32x4*)(gain + 4 * lane + 256 * j);
    for (int row = vwg * 8 + wave; row < T; row += G * 8) {
        f32x4* xr = (f32x4*)(X + (size_t)row * D) + lane; const u32x2* dr = (const u32x2*)(H + (size_t)row * D) + lane;
        f32x4 v[4]; float s = 0.f;
#pragma unroll
        for (int j = 0; j < 4; ++j) { const u32x2 d = dr[64 * j]; v[j] = xr[64 * j] + (f32x4){bflo(d.x), bfhi(d.x), bflo(d.y), bfhi(d.y)}; s += (v[j][0] * v[j][0] + v[j][1] * v[j][1]) + (v[j][2] * v[j][2] + v[j][3] * v[j][3]); }
        const float rstd = 1.0f / sqrtf(wave_sum(s) * (1.f / D) + EPS);
#pragma unroll
        for (int j = 0; j < 4; ++j) xr[64 * j] = (v[j] * rstd) * A[j];
    }
}

__device__ __forceinline__ __amdgpu_buffer_rsrc_t mk_rsrc(const void* p) { return __builtin_amdgcn_make_buffer_rsrc((void*)p, 0, 0x7fffffff, 0x00020000); }
__device__ __forceinline__ void att_phase(LAS unsigned char* lds, const bf16_t* PA, bf16_t* MRG, const float* sinks, int vwg, int G, int do_conv, const LayerW& Lc, unsigned char* wswc, const LayerW& Ln, unsigned char* wswn) {
    const int tid = otid(), lane = tid & 63, w = __builtin_amdgcn_readfirstlane(tid >> 6), lr = lane & 15, lq = lane >> 4;
    LAS unsigned char* Kimg = lds;
    LAS unsigned char* VT = lds + 36864;
    const __amdgpu_buffer_rsrc_t rPA = mk_rsrc(PA), rMR = mk_rsrc(MRG);
    const unsigned qvo = ((unsigned)lr * NA + 8u * lq) * 2u;
    const unsigned gvo = ((unsigned)lr * NA + 4u * lq) * 2u;
    const unsigned ovo = ((unsigned)lr * D + 4u * lq) * 2u;
    for (int e = tid; e < 64 * 16; e += 512) *(LAS bf16_t*)(VT + (e >> 4) * 560 + (256 + (e & 15)) * 2) = 0;
    LAS float* cscr = (LAS float*)(lds + 72704 + w * 8448);
    const int cgw = vwg * 8 + w, cNGW = G * 8; int cslot = 0;
    for (int item = vwg; item < 512; item += G) {
        const int g = item & 1, nbk = (item >> 1) & 31, b = item >> 6;
        const int t0 = b * SEQ + nbk * 128;
        const int hq = 8 * g + w;
        u32x4 qn0 = __builtin_amdgcn_raw_buffer_load_b128(rPA, qvo, (t0 * NA + hq * 64) * 2, 0), qn1 = __builtin_amdgcn_raw_buffer_load_b128(rPA, qvo, (t0 * NA + hq * 64 + 32) * 2, 0);
        u32x2 gn_[4];
#pragma unroll
        for (int dt = 0; dt < 4; ++dt) gn_[dt] = __builtin_amdgcn_raw_buffer_load_b64(rPA, gvo, (t0 * NA + 1280 + hq * 64 + 16 * dt) * 2, 0);
        __syncthreads();
#pragma unroll
        for (int c = 0; c < 4; ++c) {
            const int id = tid + 512 * c, row = id >> 3, piece = id & 7;
            u32x4 kv = {0u, 0u, 0u, 0u}, vv = {0u, 0u, 0u, 0u};
            if (nbk > 0 || row >= 128) { const bf16_t* p = PA + (size_t)(t0 - 128 + row) * NA + 1024 + 64 * g + 8 * piece; kv = *(const u32x4*)p; vv = *(const u32x4*)(p + 128); }
            *(LAS u32x4*)(Kimg + row * 144 + piece * 16) = kv;
            LAS bf16_t* vt = (LAS bf16_t*)VT + (8 * piece) * 280 + row;
            vt[0 * 280] = (bf16_t)(vv.x & 0xffffu); vt[1 * 280] = (bf16_t)(vv.x >> 16); vt[2 * 280] = (bf16_t)(vv.y & 0xffffu); vt[3 * 280] = (bf16_t)(vv.y >> 16);
            vt[4 * 280] = (bf16_t)(vv.z & 0xffffu); vt[5 * 280] = (bf16_t)(vv.z >> 16); vt[6 * 280] = (bf16_t)(vv.w & 0xffffu); vt[7 * 280] = (bf16_t)(vv.w >> 16);
        }
        __syncthreads();
        const float sink = sinks[hq];
        for (int mt = 0; mt < 8; ++mt) {
            const bf16x8 qf0 = __builtin_bit_cast(bf16x8, qn0), qf1 = __builtin_bit_cast(bf16x8, qn1);
            u32x2 gc[4];
#pragma unroll
            for (int dt = 0; dt < 4; ++dt) gc[dt] = gn_[dt];
            if (mt + 1 < 8) {
                const int tn = (t0 + 16 * (mt + 1)) * NA;
                qn0 = __builtin_amdgcn_raw_buffer_load_b128(rPA, qvo, (tn + hq * 64) * 2, 0); qn1 = __builtin_amdgcn_raw_buffer_load_b128(rPA, qvo, (tn + hq * 64 + 32) * 2, 0);
#pragma unroll
                for (int dt = 0; dt < 4; ++dt) gn_[dt] = __builtin_amdgcn_raw_buffer_load_b64(rPA, gvo, (tn + 1280 + hq * 64 + 16 * dt) * 2, 0);
            }
            const int cit = cgw + cslot * cNGW; const bool cdo = do_conv && cit < CONV_LATE + CONV_NITEMS;
            ConvItem ci; float tv[32];
            if (cdo) { ci = (cit < CONV_LATE) ? conv_decode_late(cit, Lc, wswc) : conv_decode(cit - CONV_LATE, Ln, wswn); tr_load(ci, lane, tv); }
            f32x4 s[9];
#pragma unroll
            for (int a = 0; a < 9; ++a) {
                const LAS unsigned char* kp = Kimg + (16 * (mt + a) + lr) * 144 + lq * 16;
                const bf16x8 k0 = *(const LAS bf16x8*)kp, k1 = *(const LAS bf16x8*)(kp + 64);
                f32x4 z = {0.f, 0.f, 0.f, 0.f};
                z = mfma16(k0, qf0, z); z = mfma16(k1, qf1, z); s[a] = z;
            }
            const int i = 16 * mt + lr;
            float mx = sink;
#pragma unroll
            for (int a = 0; a < 9; ++a)
#pragma unroll
                for (int r = 0; r < 4; ++r) { const int j = 16 * (mt + a) + 4 * lq + r, dd = j - i; const bool valid = (dd >= 1) && (dd <= 128) && (nbk > 0 || j >= 128);
                    const float v = valid ? s[a][r] : -INFINITY; s[a][r] = v; mx = fmaxf(mx, v); }
            mx = fmaxf(mx, __shfl_xor(mx, 16)); mx = fmaxf(mx, __shfl_xor(mx, 32));
            float sum = 0.f;
#pragma unroll
            for (int a = 0; a < 9; ++a)
#pragma unroll
                for (int r = 0; r < 4; ++r) { const float p = __expf(s[a][r] - mx); s[a][r] = p; sum += p; }
            sum += __shfl_xor(sum, 16); sum += __shfl_xor(sum, 32);
            const float inv = 1.0f / (sum + __expf(sink - mx));
            bf16x8 pf[5];
#pragma unroll
            for (int kk = 0; kk < 5; ++kk) {
                u32x4 wv; wv.x = pg8::cvt_pk_bf16(s[2 * kk][0] * inv, s[2 * kk][1] * inv); wv.y = pg8::cvt_pk_bf16(s[2 * kk][2] * inv, s[2 * kk][3] * inv);
                if (kk < 4) { wv.z = pg8::cvt_pk_bf16(s[2 * kk + 1][0] * inv, s[2 * kk + 1][1] * inv); wv.w = pg8::cvt_pk_bf16(s[2 * kk + 1][2] * inv, s[2 * kk + 1][3] * inv); } else { wv.z = 0u; wv.w = 0u; }
                pf[kk] = __builtin_bit_cast(bf16x8, wv);
            }
#pragma unroll
            for (int dt = 0; dt < 4; ++dt) {
                f32x4 o = {0.f, 0.f, 0.f, 0.f};
#pragma unroll
                for (int kk = 0; kk < 5; ++kk) {
                    const LAS unsigned char* vp = VT + (16 * dt + lr) * 560 + (16 * (mt + 2 * kk) + 4 * lq) * 2;
                    const bf16x4 v0 = *(const LAS bf16x4*)vp, v1 = *(const LAS bf16x4*)(vp + 32);
                    const bf16x8 vf = __builtin_shufflevector(v0, v1, 0, 1, 2, 3, 4, 5, 6, 7);
                    o = mfma16(vf, pf[kk], o);
                }
                const u32x2 ga = gc[dt];
                u32x2 ow; ow.x = pg8::cvt_pk_bf16(o[0] * bflo(ga.x), o[1] * bfhi(ga.x)); ow.y = pg8::cvt_pk_bf16(o[2] * bflo(ga.y), o[3] * bfhi(ga.y));
                __builtin_amdgcn_raw_buffer_store_b64(ow, rMR, ovo, ((t0 + 16 * mt) * D + hq * 64 + 16 * dt) * 2, 0);
            }
            if (cdo) tr_finish(ci, lane, tv, cscr);
            ++cslot;
        }
    }
    if (do_conv) {
        for (; cgw + cslot * cNGW < CONV_LATE + CONV_NITEMS; ++cslot) { const int cit = cgw + cslot * cNGW; float tv[32];
            const ConvItem ci = (cit < CONV_LATE) ? conv_decode_late(cit, Lc, wswc) : conv_decode(cit - CONV_LATE, Ln, wswn);
            tr_load(ci, lane, tv); tr_finish(ci, lane, tv, cscr); }
    }
}

#define LDS_BAR0() do { asm volatile("s_waitcnt lgkmcnt(0)" ::: "memory"); __builtin_amdgcn_s_barrier(); asm volatile("" ::: "memory"); } while (0)
constexpr int G2_QG = 0, G2_KR = 17408, G2_KGT = 34816, G2_VT = 53248, G2_AT = 90112, G2_DEC = 99328, G2_TOT = 99840, G2_RED = 103936, G2_DSG = 105984, G2_LRS = 110080;
template <int PASS>
__device__ __forceinline__ void gla2_phase(LAS unsigned char* lds, const bf16_t* PB, bf16_t* MRG, float* SLOC, float* DSEG, const float* gn, int vwg, int G, bf16_t* MRGO, const float* LRp, const float* wgp, const float* bgp) {
    const int tid = otid(), lane = tid & 63, w = __builtin_amdgcn_readfirstlane(tid >> 6), lr = lane & 15, lq = lane >> 4;
    LAS unsigned char *QG = lds + G2_QG, *KR = lds + G2_KR, *KGT = lds + G2_KGT, *VT = lds + G2_VT, *AT = lds + G2_AT;
    LAS float* DEC = (LAS float*)(lds + G2_DEC); LAS float* TOT = (LAS float*)(lds + G2_TOT); LAS float* RED = (LAS float*)(lds + G2_RED); LAS float* DSG = (LAS float*)(lds + G2_DSG); LAS float* LRS = (LAS float*)(lds + G2_LRS);
    const __amdgpu_buffer_rsrc_t rPB = mk_rsrc(PB), rMR = mk_rsrc(MRG), rSL = mk_rsrc(SLOC), rMO = mk_rsrc(MRGO), rLR = mk_rsrc(LRp);
    for (int item = vwg; item < 256; item += G) {
        const int seg = item & 7, bh = item >> 3, h = bh & 3, b = bh >> 2;
        const size_t tb = (size_t)b * SEQ + (size_t)seg * 512;
        f32x4 st[8][2];
#pragma unroll
        for (int dt = 0; dt < 8; ++dt) { st[dt][0] = (f32x4){0.f, 0.f, 0.f, 0.f}; st[dt][1] = (f32x4){0.f, 0.f, 0.f, 0.f}; }
        __syncthreads();
        if (PASS == 2 && seg > 0) {
            if (tid < 128) for (int sp = 0; sp < seg; ++sp) DSG[sp * 128 + tid] = DSEG[(size_t)(bh * 8 + sp) * 128 + tid];
            const unsigned slo = (unsigned)lane * 4u;
            float cur[64];
            { const int slu = ((bh * 8 + 0) * 8 + w) * 64 * 256;
#pragma unroll
              for (int q = 0; q < 64; ++q) cur[q] = __uint_as_float(__builtin_amdgcn_raw_buffer_load_b32(rSL, slo, slu + q * 256, 0)); }
            __syncthreads();
            for (int sp = 0; sp < seg; ++sp) {
                const int slun = ((bh * 8 + (sp + 1 < seg ? sp + 1 : sp)) * 8 + w) * 64 * 256;
#pragma unroll
                for (int dt = 0; dt < 8; ++dt) { const f32x4 dc = *(const LAS f32x4*)(DSG + sp * 128 + 16 * dt + 4 * lq);
#pragma unroll
                    for (int vt = 0; vt < 2; ++vt)
#pragma unroll
                        for (int r = 0; r < 4; ++r) { const int q = (dt * 2 + vt) * 4 + r; st[dt][vt][r] = st[dt][vt][r] * dc[r] + cur[q];
                            cur[q] = __uint_as_float(__builtin_amdgcn_raw_buffer_load_b32(rSL, slo, slun + q * 256, 0)); } }
            }
            __syncthreads();
        }
        const int dp = tid & 63, part = w, tp = tid & 31, cgp = tid >> 5;
        const int qub = (int)(((tb + 8 * part) * NB + h * 128) * 2);
        const unsigned qvo = (unsigned)dp * 4u;
        const int vub = (int)((tb * NB + 1024 + h * 256) * 2);
        const unsigned vvo = ((unsigned)(2 * tp) * NB + 16u * cgp) * 2u;
        const unsigned evo = ((unsigned)lr * NB + 4u * lq) * 2u, mvo = ((unsigned)lr * D + 4u * lq) * 2u;
        float segdec0 = 1.f, segdec1 = 1.f;
        float wg0[16], wg1[16], bg0 = 0.f, bg1 = 0.f; u32x4 lrn = {0u, 0u, 0u, 0u};
        if (PASS == 1) {
#pragma unroll
            for (int r = 0; r < 16; ++r) { const f32x2_t t = *(const f32x2_t*)(wgp + r * 512 + h * 128 + 2 * dp); wg0[r] = t.x; wg1[r] = t.y; }
            { const f32x2_t t = *(const f32x2_t*)(bgp + h * 128 + 2 * dp); bg0 = t.x; bg1 = t.y; }
            if (tid < 256) lrn = __builtin_amdgcn_raw_buffer_load_b128(rLR, (unsigned)tid * 16u, (int)(tb * 64), 0);
        }
        unsigned rq[8], rk[8], rg[8]; u32x4 rv[4];
#pragma unroll
        for (int e = 0; e < 8; ++e) { const int p = qub + e * NB * 2; if (PASS == 2) rq[e] = __builtin_amdgcn_raw_buffer_load_b32(rPB, qvo, p, 0); rk[e] = __builtin_amdgcn_raw_buffer_load_b32(rPB, qvo, p + 1024, 0); if (PASS == 2) rg[e] = __builtin_amdgcn_raw_buffer_load_b32(rPB, qvo, p + 6144, 0); }
#pragma unroll
        for (int e = 0; e < 2; ++e) { const int p = vub + e * NB * 2; rv[2 * e] = __builtin_amdgcn_raw_buffer_load_b128(rPB, vvo, p, 0); rv[2 * e + 1] = __builtin_amdgcn_raw_buffer_load_b128(rPB, vvo, p + 16, 0); }
        for (int c = 0; c < 8; ++c) {
            if (PASS == 1) {
                if (tid < 256) *(LAS u32x4*)(LRS + tid * 4) = lrn;
                if (c + 1 < 8 && tid < 256) lrn = __builtin_amdgcn_raw_buffer_load_b128(rLR, (unsigned)tid * 16u, (int)((tb + 64 * (c + 1)) * 64), 0);
                LDS_BAR0();
#pragma unroll
                for (int e = 0; e < 8; ++e) {
                    const LAS f32x4* lp = (const LAS f32x4*)(LRS + (8 * part + e) * 16);
                    float s0 = bg0, s1 = bg1;
#pragma unroll
                    for (int q = 0; q < 4; ++q) { const f32x4 lv = lp[q];
#pragma unroll
                        for (int j = 0; j < 4; ++j) { s0 += lv[j] * wg0[4 * q + j]; s1 += lv[j] * wg1[4 * q + j]; } }
                    const float a0 = (fminf(s0, 0.f) - __logf(1.f + __expf(-fabsf(s0)))) * 0.0625f, a1 = (fminf(s1, 0.f) - __logf(1.f + __expf(-fabsf(s1)))) * 0.0625f;
                    rg[e] = pg8::cvt_pk_bf16(a0, a1);
                    __builtin_amdgcn_raw_buffer_store_b32(rg[e], rPB, qvo, qub + (64 * c + e) * NB * 2 + 6144, 0);
                }
            }
            float G0[8], G1[8]; float run0 = 0.f, run1 = 0.f;
#pragma unroll
            for (int e = 0; e < 8; ++e) { run0 += bflo(rg[e]); run1 += bfhi(rg[e]); G0[e] = run0; G1[e] = run1; }
            *(LAS f32x2_t*)(TOT + part * 128 + 2 * dp) = (f32x2_t){run0, run1};
            __syncthreads();
            float off0 = 0.f, off1 = 0.f, gl0 = 0.f, gl1 = 0.f;
#pragma unroll
            for (int p = 0; p < 8; ++p) { const f32x2_t t = *(const LAS f32x2_t*)(TOT + p * 128 + 2 * dp); gl0 += t.x; gl1 += t.y; if (p < part) { off0 += t.x; off1 += t.y; } }
            const float dec0 = __expf(gl0), dec1 = __expf(gl1);
            if (part == 0) { *(LAS f32x2_t*)(DEC + 2 * dp) = (f32x2_t){dec0, dec1}; segdec0 *= dec0; segdec1 *= dec1; }
            { float kgA[8], kgB[8];
#pragma unroll
              for (int e = 0; e < 8; ++e) {
                  const float eg0 = __expf(G0[e] + off0), eg1 = __expf(G1[e] + off1), ie0 = __builtin_amdgcn_rcpf(eg0), ie1 = __builtin_amdgcn_rcpf(eg1);
                  const float kr0 = bflo(rk[e]) * ie0, kr1 = bfhi(rk[e]) * ie1; kgA[e] = kr0 * dec0; kgB[e] = kr1 * dec1;
                  if (PASS == 2) { *(LAS unsigned*)(QG + (8 * part + e) * 272 + dp * 4) = pg8::cvt_pk_bf16(bflo(rq[e]) * eg0, bfhi(rq[e]) * eg1);
                                   *(LAS unsigned*)(KR + (8 * part + e) * 272 + dp * 4) = pg8::cvt_pk_bf16(kr0, kr1); } }
              u32x4 wa, wb; wa.x = pg8::cvt_pk_bf16(kgA[0], kgA[1]); wa.y = pg8::cvt_pk_bf16(kgA[2], kgA[3]); wa.z = pg8::cvt_pk_bf16(kgA[4], kgA[5]); wa.w = pg8::cvt_pk_bf16(kgA[6], kgA[7]);
              wb.x = pg8::cvt_pk_bf16(kgB[0], kgB[1]); wb.y = pg8::cvt_pk_bf16(kgB[2], kgB[3]); wb.z = pg8::cvt_pk_bf16(kgB[4], kgB[5]); wb.w = pg8::cvt_pk_bf16(kgB[6], kgB[7]);
              *(LAS u32x4*)(KGT + (2 * dp) * 144 + part * 16) = wa; *(LAS u32x4*)(KGT + (2 * dp + 1) * 144 + part * 16) = wb; }
            { const u32x4 va0 = rv[0], va1 = rv[1], vb0 = rv[2], vb1 = rv[3];
              const unsigned av[8] = {va0.x, va0.y, va0.z, va0.w, va1.x, va1.y, va1.z, va1.w}, bv[8] = {vb0.x, vb0.y, vb0.z, vb0.w, vb1.x, vb1.y, vb1.z, vb1.w};
              LAS unsigned char* vp = VT + (16 * cgp) * 144 + tp * 4;
#pragma unroll
              for (int m = 0; m < 8; ++m) { *(LAS unsigned*)(vp + (2 * m) * 144) = (av[m] & 0xffffu) | (bv[m] << 16); *(LAS unsigned*)(vp + (2 * m + 1) * 144) = (av[m] >> 16) | (bv[m] & 0xffff0000u); } }
            __syncthreads();
            if (c + 1 < 8)
            {
#pragma unroll
                for (int e = 0; e < 8; ++e) { const int p = qub + (64 * (c + 1) + e) * NB * 2; if (PASS == 2) rq[e] = __builtin_amdgcn_raw_buffer_load_b32(rPB, qvo, p, 0); rk[e] = __builtin_amdgcn_raw_buffer_load_b32(rPB, qvo, p + 1024, 0); if (PASS == 2) rg[e] = __builtin_amdgcn_raw_buffer_load_b32(rPB, qvo, p + 6144, 0); }
#pragma unroll
                for (int e = 0; e < 2; ++e) { const int p = vub + (64 * (c + 1) + e) * NB * 2; rv[2 * e] = __builtin_amdgcn_raw_buffer_load_b128(rPB, vvo, p, 0); rv[2 * e + 1] = __builtin_amdgcn_raw_buffer_load_b128(rPB, vvo, p + 16, 0); }
            }
            f32x4 oacc[4][2];
            if (PASS == 2) {
#pragma unroll
                for (int u2 = 0; u2 < 2; ++u2) {
                    const int id = 2 * w + u2, it = id >> 2, jt = id & 3;
                    f32x4 a = {0.f, 0.f, 0.f, 0.f};
                    if (jt <= it) {
#pragma unroll
                        for (int ks = 0; ks < 4; ++ks) {
                            const bf16x8 kf = *(const LAS bf16x8*)(KR + (16 * jt + lr) * 272 + (32 * ks + 8 * lq) * 2);
                            const bf16x8 qf = *(const LAS bf16x8*)(QG + (16 * it + lr) * 272 + (32 * ks + 8 * lq) * 2);
                            a = mfma16(kf, qf, a);
                        }
                        if (jt == it) {
#pragma unroll
                            for (int r = 0; r < 4; ++r) if (4 * lq + r > lr) a[r] = 0.f; }
                    }
                    u32x2 pk; pk.x = pg8::cvt_pk_bf16(a[0], a[1]); pk.y = pg8::cvt_pk_bf16(a[2], a[3]);
                    *(LAS u32x2*)(AT + (16 * it + lr) * 144 + (16 * jt + 4 * lq) * 2) = pk;
                }
#pragma unroll
                for (int it = 0; it < 4; ++it) { oacc[it][0] = (f32x4){0.f, 0.f, 0.f, 0.f}; oacc[it][1] = (f32x4){0.f, 0.f, 0.f, 0.f}; }
#pragma unroll
                for (int ks = 0; ks < 4; ++ks) {
                    bf16x8 sf[2];
#pragma unroll
                    for (int vt = 0; vt < 2; ++vt) { u32x4 t; t.x = pg8::cvt_pk_bf16(st[2 * ks][vt][0], st[2 * ks][vt][1]); t.y = pg8::cvt_pk_bf16(st[2 * ks][vt][2], st[2 * ks][vt][3]);
                        t.z = pg8::cvt_pk_bf16(st[2 * ks + 1][vt][0], st[2 * ks + 1][vt][1]); t.w = pg8::cvt_pk_bf16(st[2 * ks + 1][vt][2], st[2 * ks + 1][vt][3]); sf[vt] = __builtin_bit_cast(bf16x8, t); }
#pragma unroll
                    for (int it = 0; it < 4; ++it) {
                        const LAS unsigned char* qp = QG + (16 * it + lr) * 272 + (32 * ks + 4 * lq) * 2;
                        const bf16x4 qa = *(const LAS bf16x4*)qp, qb = *(const LAS bf16x4*)(qp + 32);
                        const bf16x8 qf = __builtin_shufflevector(qa, qb, 0, 1, 2, 3, 4, 5, 6, 7);
                        oacc[it][0] = mfma16(sf[0], qf, oacc[it][0]); oacc[it][1] = mfma16(sf[1], qf, oacc[it][1]);
                    }
                }
                __syncthreads();
            }
            u32x2 er[4][2], ey[4][2];
            __builtin_amdgcn_sched_barrier(0);
            if (PASS == 2) {
#pragma unroll
                for (int it = 0; it < 4; ++it)
#pragma unroll
                    for (int vt = 0; vt < 2; ++vt) { const size_t tku = tb + 64 * c + 16 * it; const int colu = h * 256 + 32 * w + 16 * vt;
                        const int pu = (int)((tku * NB + 2048 + colu) * 2), mu = (int)((tku * D + colu) * 2);
                        er[it][vt] = __builtin_amdgcn_raw_buffer_load_b64(rPB, evo, pu, 0); ey[it][vt] = __builtin_amdgcn_raw_buffer_load_b64(rMR, mvo, mu, 0); }
            }
            bf16x8 vf[2][2];
#pragma unroll
            for (int vt = 0; vt < 2; ++vt)
#pragma unroll
                for (int ks = 0; ks < 2; ++ks) vf[vt][ks] = *(const LAS bf16x8*)(VT + (32 * w + 16 * vt + lr) * 144 + (32 * ks + 8 * lq) * 2);
            if (PASS == 2) {
#pragma unroll
                for (int it = 0; it < 4; ++it)
#pragma unroll
                    for (int ks = 0; ks < 2; ++ks) { if (ks == 1 && it < 2) continue;
                        const bf16x8 af = *(const LAS bf16x8*)(AT + (16 * it + lr) * 144 + (32 * ks + 8 * lq) * 2);
                        oacc[it][0] = mfma16(vf[0][ks], af, oacc[it][0]); oacc[it][1] = mfma16(vf[1][ks], af, oacc[it][1]); }
            }
            u32x2 opk[4][2];
            if (PASS == 2) {
#pragma unroll
                for (int it = 0; it < 4; ++it) { float s = 0.f;
#pragma unroll
                    for (int vt = 0; vt < 2; ++vt)
#pragma unroll
                        for (int r = 0; r < 4; ++r) s += oacc[it][vt][r] * oacc[it][vt][r];
                    s += __shfl_xor(s, 16); s += __shfl_xor(s, 32);
                    if (lq == 0) RED[w * 64 + 16 * it + lr] = s; }
#pragma unroll
                for (int it = 0; it < 4; ++it)
#pragma unroll
                    for (int vt = 0; vt < 2; ++vt) { opk[it][vt].x = pg8::cvt_pk_bf16(oacc[it][vt][0], oacc[it][vt][1]); opk[it][vt].y = pg8::cvt_pk_bf16(oacc[it][vt][2], oacc[it][vt][3]); }
            }
            __builtin_amdgcn_sched_barrier(0);
#pragma unroll
            for (int dt = 0; dt < 8; ++dt) {
                const f32x4 dc = *(const LAS f32x4*)(DEC + 16 * dt + 4 * lq);
                st[dt][0] = st[dt][0] * dc; st[dt][1] = st[dt][1] * dc;
#pragma unroll
                for (int ks = 0; ks < 2; ++ks) { const bf16x8 kf = *(const LAS bf16x8*)(KGT + (16 * dt + lr) * 144 + (32 * ks + 8 * lq) * 2);
                    st[dt][0] = mfma16(kf, vf[0][ks], st[dt][0]); st[dt][1] = mfma16(kf, vf[1][ks], st[dt][1]); }
            }
            __builtin_amdgcn_sched_barrier(0);
            if (PASS == 2) {
                __syncthreads();
#pragma unroll
                for (int half = 0; half < 2; ++half) {
#pragma unroll
                    for (int it2 = 0; it2 < 2; ++it2) { const int it = 2 * half + it2; float ss = 0.f;
#pragma unroll
                        for (int ww = 0; ww < 8; ++ww) ss += RED[ww * 64 + 16 * it + lr];
                        const float rstd = 1.0f / sqrtf(ss * (1.f / 256.f) + EPS);
#pragma unroll
                        for (int vt = 0; vt < 2; ++vt) { const size_t tku = tb + 64 * c + 16 * it; const int colu = h * 256 + 32 * w + 16 * vt;
                            const f32x4 gnv = *(const f32x4*)(gn + 32 * w + 16 * vt + 4 * lq);
                            const f32x4 ou = {bflo(opk[it][vt].x), bfhi(opk[it][vt].x), bflo(opk[it][vt].y), bfhi(opk[it][vt].y)};
                            const f32x4 o = ou * rstd * gnv;
                            const float y0 = bflo(ey[it][vt].x) + o[0] * bflo(er[it][vt].x), y1 = bfhi(ey[it][vt].x) + o[1] * bfhi(er[it][vt].x);
                            const float y2 = bflo(ey[it][vt].y) + o[2] * bflo(er[it][vt].y), y3 = bfhi(ey[it][vt].y) + o[3] * bfhi(er[it][vt].y);
                            u32x2 ow; ow.x = pg8::cvt_pk_bf16(y0, y1); ow.y = pg8::cvt_pk_bf16(y2, y3);
                            __builtin_amdgcn_raw_buffer_store_b64(ow, rMO, mvo, (int)((tku * D + colu) * 2), 0); } }
                }
            }
        }
        if (PASS == 1) {
            const int slu = ((bh * 8 + seg) * 8 + w) * 64 * 256; const unsigned slo = (unsigned)lane * 4u;
#pragma unroll
            for (int dt = 0; dt < 8; ++dt)
#pragma unroll
                for (int vt = 0; vt < 2; ++vt)
#pragma unroll
                    for (int r = 0; r < 4; ++r) __builtin_amdgcn_raw_buffer_store_b32(__float_as_uint(st[dt][vt][r]), rSL, slo, slu + ((dt * 2 + vt) * 4 + r) * 256, 0);
            if (part == 0) { DSEG[(size_t)(bh * 8 + seg) * 128 + 2 * dp] = segdec0; DSEG[(size_t)(bh * 8 + seg) * 128 + 2 * dp + 1] = segdec1; }
        }
    }
}

typedef __attribute__((address_space(1))) unsigned gu32;
#define XB_TMO      128
#define XB_XCNT(j)  (256  + 64 * (j))
#define XB_XSUB(j)  (1280 + 64 * (j))
#define XB_XGEN(j)  (2304 + 64 * (j))
#define XB_TOP      3328
#define XB_TOPGEN   3392
#define XCD_BAR_WORDS 3456
#define XB_SPIN_CAP (1u << 22)

__device__ __forceinline__ unsigned xb_ld(unsigned* p)              { return __hip_atomic_load(p, __ATOMIC_RELAXED, __HIP_MEMORY_SCOPE_AGENT); }
__device__ __forceinline__ unsigned xb_add(unsigned* p, unsigned v) { return __hip_atomic_fetch_add(p, v, __ATOMIC_RELAXED, __HIP_MEMORY_SCOPE_AGENT); }
__device__ __forceinline__ unsigned xb_xcc_id() { return (unsigned)__builtin_amdgcn_s_getreg((3 << 11) | 20) & 0xFu; }
#define XB_SPIN(cond, bar) do { unsigned _sp = 0; while (cond) { __builtin_amdgcn_s_sleep(1); \
    if ((++_sp & 255u) == 0u) { if (xb_ld(&(bar)[XB_TMO])) break; if (_sp > XB_SPIN_CAP) { atomicAdd(&(bar)[XB_TMO], 1u); break; } } } } while (0)

struct XcdBarrier {
    unsigned* bar; unsigned x;
    volatile LAS unsigned* st;
};

__device__ __forceinline__ XcdBarrier xcd_barrier_post(unsigned* bar, volatile LAS unsigned* st) {
    XcdBarrier b; b.bar = bar; b.x = xb_xcc_id(); b.st = st;
    if (threadIdx.x == 0) (void)xb_add(&bar[XB_XCNT(b.x)], 1u);
    return b;
}
__device__ __forceinline__ void xcd_barrier_complete(unsigned* bar, unsigned x, unsigned& nloc, unsigned& nx) {
    const unsigned G = gridDim.x * gridDim.y * gridDim.z;
    unsigned sum, cnt, mine, sp = 0u;
    for (;;) {
        sum = 0u; cnt = 0u; mine = 0u;
#pragma unroll
        for (unsigned j = 0; j < 16; ++j) { const unsigned c = xb_ld(&bar[XB_XCNT(j)]); sum += c; cnt += (c > 0u) ? 1u : 0u; mine = (j == x) ? c : mine; }
        if (sum == G) break;
        __builtin_amdgcn_s_sleep(1);
        if ((++sp & 255u) == 0u) { if (xb_ld(&bar[XB_TMO])) break; if (sp > XB_SPIN_CAP) { atomicAdd(&bar[XB_TMO], 1u); break; } }
    }
    nloc = mine > 0u ? mine : 1u; nx = cnt > 0u ? cnt : 1u;
}

__device__ __forceinline__ void xcd_barrier(const XcdBarrier& b) {
    asm volatile("s_waitcnt vmcnt(0)" ::: "memory");
    __syncthreads();
    if (threadIdx.x == 0) {
        unsigned* bar = b.bar;
        __builtin_amdgcn_s_waitcnt(0);
        unsigned nloc = b.st[0], nx = b.st[1];
        if (nloc == 0u) { xcd_barrier_complete(bar, b.x, nloc, nx); b.st[0] = nloc; b.st[1] = nx; }
        const unsigned old = xb_add(&bar[XB_XSUB(b.x)], 1u);
        const unsigned gen = old / nloc;
        if (old + 1u == (gen + 1u) * nloc) {
            __builtin_amdgcn_fence(__ATOMIC_RELEASE, "agent");
            asm volatile("s_waitcnt vmcnt(0)" ::: "memory");
            const unsigned og = xb_add(&bar[XB_TOP], 1u);
            const unsigned tg = og / nx;
            if (og + 1u == (tg + 1u) * nx) xb_add(&bar[XB_TOPGEN], 1u);
            else XB_SPIN(xb_ld(&bar[XB_TOPGEN]) == tg, bar);
            __builtin_amdgcn_fence(__ATOMIC_ACQUIRE, "agent");
            xb_add(&bar[XB_XGEN(b.x)], 1u);
            asm volatile("s_waitcnt vmcnt(0)" ::: "memory");
        } else {
            XB_SPIN(xb_ld(&bar[XB_XGEN(b.x)]) == gen, bar);
            __builtin_amdgcn_fence(__ATOMIC_ACQUIRE, "agent");
            asm volatile("s_waitcnt vmcnt(0)" ::: "memory");
        }
    }
    __syncthreads();
}

struct Args { const float* in[18]; float* out; unsigned char* ws; int ph_lo, ph_hi; };
constexpr int PH_PER_LAYER = 14;
constexpr int NPH = 2 * PH_PER_LAYER + 1;

__global__ void __launch_bounds__(512, 2) mega_fwd(Args a) {
    extern __shared__ __attribute__((aligned(16))) unsigned char lds_raw[];
    LAS unsigned char* lds = (LAS unsigned char*)lds_raw;
    cg::grid_group grid = cg::this_grid();
    volatile LAS unsigned* MISC = (volatile LAS unsigned*)(lds + LDS_BYTES - 512);
    if (threadIdx.x < 32) MISC[threadIdx.x] = 0u;
    __syncthreads();
    XcdBarrier bar = xcd_barrier_post((unsigned*)(a.ws + WS_CTL) + 4096, MISC + 8);
    if (a.ph_lo < 0) grid.sync();
    const int G = gridDim.x, bx = blockIdx.x;
    const int vwg = (G % 8 == 0) ? (bx % 8) * (G / 8) + bx / 8 : bx;
    unsigned char* ws = a.ws;
    float* MOD = (float*)(ws + WS_MOD);
    bf16_t* H = (bf16_t*)(ws + WS_H); bf16_t* MRG = (bf16_t*)(ws + WS_MRG); bf16_t* PROJ = (bf16_t*)(ws + WS_PROJ);
    float* X = a.out;
    for (int ph0 = a.ph_lo; ph0 < a.ph_hi; ++ph0) {
        const int ph = ph0;
        if (ph == NPH - 1) { final_norm_phase(X, H, a.in[17], vwg, G); }
        else {
            const int l = ph / PH_PER_LAYER, p = ph % PH_PER_LAYER;
            const float* modl = MOD + (size_t)l * 8 * NMOD; unsigned char* wsw = ws + WS_W + (size_t)l * WS_WSTRIDE;
            if (p == 0 && l == 1) {   }
            else if (p == 0) {
                if (l == 0) mod_phase(lds, a.in[1], a.in[2], a.in[3], MOD, vwg, G, 0);
                __syncthreads();
                LayerW L; L.f1in = a.in[5] + (size_t)l * D * NFF2; L.f1out = a.in[6] + (size_t)l * FF * D; L.mixin = a.in[8] + (size_t)l * D * INC; L.wgate = a.in[10] + (size_t)l * 16 * 512;
                L.mixout = a.in[13] + (size_t)l * D * D; L.f2in = a.in[15] + (size_t)l * D * NFF2; L.f2out = a.in[16] + (size_t)l * FF * D;
                wconv_phase(lds, L, wsw, vwg, G);
            } else if (p == 1 || p == 4 || p == 11) {
                const int q = (p == 1) ? 0 : (p == 4 ? 1 : 2);
                const float* gain = a.in[q == 0 ? 4 : (q == 1 ? 7 : 14)] + (size_t)l * D;
                const bool from_input = (l == 0 && p <= 4);
                norm_phase(from_input ? a.in[0] : X, X, H, (l == 0 && p == 1) ? 0 : 1, gain, modl + (3 * q) * D, modl + (3 * q + 1) * D, vwg, G);
            } else if (p == 2 || p == 12) {
                pg8::Gemm g{H, (const bf16_t*)(wsw + (p == 2 ? W_1IN : W_2IN)), T, NFF2, D}; pg8::StaticOrder S; S.init(T, NFF2, G, bx);
                EpiSwiGLU E{PROJ};
                pg8::gemm_phase<EpiSwiGLU, pg8::StaticOrder, true, true>(lds, g, S, E);
            } else if (p == 3 || p == 10 || p == 13) {
                const bf16_t* Aop = (p == 10) ? MRG : PROJ; const int K = (p == 10) ? D : FF;
                const bf16_t* Bop = (const bf16_t*)(wsw + (p == 3 ? W_1OUT : (p == 10 ? W_O : W_2OUT)));
                pg8::Gemm g{Aop, Bop, T, D, K}; pg8::StaticOrder S; S.init(T, D, G, bx);
                EpiResid E{H, modl + (p == 3 ? 2 : (p == 10 ? 5 : 8)) * D, p == 10 ? 1.0f : 0.5f};
                pg8::gemm_phase<EpiResid, pg8::StaticOrder, true, true>(lds, g, S, E);
            } else if (p == 5 || p == 7) {
                const int N = (p == 5) ? NAG : NBG;
                pg8::Gemm g{H, (const bf16_t*)(wsw + (p == 5 ? W_A : W_B)), T, N, D}; pg8::StaticOrder S; S.init(T, N, G, bx);
                EpiProj E{PROJ, p == 5 ? NA : NB, p == 5 ? 0 : 1, (float*)(ws + WS_LR)};
                pg8::gemm_phase<EpiProj, pg8::StaticOrder, true, true>(lds, g, S, E);
            } else if (p == 6) {
                LayerW Ln; { const int ln = 1; Ln.f1in = a.in[5] + (size_t)ln * D * NFF2; Ln.f1out = a.in[6] + (size_t)ln * FF * D; Ln.mixin = a.in[8] + (size_t)ln * D * INC; Ln.wgate = a.in[10] + (size_t)ln * 16 * 512;
                    Ln.mixout = a.in[13] + (size_t)ln * D * D; Ln.f2in = a.in[15] + (size_t)ln * D * NFF2; Ln.f2out = a.in[16] + (size_t)ln * FF * D; }
                LayerW Lc; Lc.f1in = a.in[5]; Lc.f1out = a.in[6]; Lc.mixin = a.in[8]; Lc.wgate = a.in[10]; Lc.mixout = a.in[13]; Lc.f2in = a.in[15]; Lc.f2out = a.in[16];
                att_phase(lds, PROJ, MRG, a.in[9] + l * 16, vwg, G, l == 0 ? 1 : 0, Lc, ws + WS_W, Ln, ws + WS_W + WS_WSTRIDE);
            } else if (p == 8) {
                if (l == 0) { mod_phase(lds, a.in[1], a.in[2], a.in[3], MOD, vwg, G, 1); __syncthreads(); }
                gla2_phase<1>(lds, PROJ, MRG, (float*)H, (float*)H + (size_t)8 * 1024 * 1024, a.in[12] + (size_t)l * 256, vwg, G, MRG, (const float*)(ws + WS_LR), a.in[10] + (size_t)l * 16 * 512, a.in[11] + (size_t)l * 512);
            } else if (p == 9) {
                gla2_phase<2>(lds, PROJ, MRG, (float*)H, (float*)H + (size_t)8 * 1024 * 1024, a.in[12] + (size_t)l * 256, vwg, G, MRG, (const float*)(ws + WS_LR), a.in[10] + (size_t)l * 16 * 512, a.in[11] + (size_t)l * 512);
            }
        }
        if (ph == PH_PER_LAYER) continue;
        if (ph0 + 1 < a.ph_hi) xcd_barrier(bar);
    }
}

extern "C" void kernel_launch(void* const* d_in, const int* in_sizes, int n_in, void* d_out, int out_size, void* d_ws, size_t ws_size, hipStream_t stream) {
    static int grid = 0;
    if (grid == 0) {
        int dev = 0, cus = 0, per_cu = 0;
        hipGetDevice(&dev); hipDeviceGetAttribute(&cus, hipDeviceAttributeMultiprocessorCount, dev);
        if (hipFuncSetAttribute((const void*)mega_fwd, hipFuncAttributeMaxDynamicSharedMemorySize, LDS_BYTES) != hipSuccess) fprintf(stderr, "hipFuncSetAttribute failed\n");
        if (hipOccupancyMaxActiveBlocksPerMultiprocessor(&per_cu, (const void*)mega_fwd, 512, LDS_BYTES) != hipSuccess || per_cu < 1) per_cu = 1;
        (void)hipGetLastError();
        grid = cus * 1;
        if (ws_size < 512 * MiB) fprintf(stderr, "kernel_launch: workspace %zu smaller than expected\n", ws_size);
    }
    (void)hipMemsetAsync((char*)d_ws + WS_CTL, 0, CTL_BYTES, stream);
    Args a{};
    for (int i = 0; i < 18; ++i) a.in[i] = (const float*)d_in[i];
    a.out = (float*)d_out; a.ws = (unsigned char*)d_ws;
    a.ph_lo = 0; a.ph_hi = NPH;
    void* args[] = {&a};
    hipError_t e = hipLaunchCooperativeKernel((const void*)mega_fwd, dim3(grid), dim3(512), args, LDS_BYTES, stream);
    if (e != hipSuccess) fprintf(stderr, "cooperative launch failed: %s (grid %d)\n", hipGetErrorString(e), grid);
}
```

```cpp
#include <hip/hip_runtime.h>
#include <hip/hip_cooperative_groups.h>
#include <cstdio>
#include <cstdint>
namespace cg = cooperative_groups;
namespace pg8 {
#define PG8_LAS __attribute__((address_space(3)))
typedef unsigned short bf16_t;
typedef short bf16x8 __attribute__((ext_vector_type(8)));
typedef float f32x4 __attribute__((ext_vector_type(4)));
typedef unsigned u32x4 __attribute__((ext_vector_type(4)));
constexpr int BM = 256, BK = 64, HALF = 128, HTB = HALF * BK * 2  , STAGE_BYTES = 8 * HTB, NXCD = 8, WGM = 8;

__host__ __device__ __forceinline__ int lds_byte(int r, int c) { const int st = (r >> 4) * 2 + (c >> 5), rr = r & 15, cc = c & 31, ob = rr * 64 + cc * 2; return st * 1024 + (ob ^ (((ob >> 9) & 1) << 5)); }
__host__ __device__ __forceinline__ void stage_rc(int b, int& R, int& C) { const int st = b / 1024, sb = b % 1024, swz = sb ^ (((sb >> 9) & 1) << 5); R = (st >> 1) * 16 + swz / 64; C = (st & 1) * 32 + (swz % 64) / 2; }
__host__ __device__ __forceinline__ int perm32(int rho) { const int n = rho >> 4, i = rho & 15; return 8 * (i >> 2) + 4 * n + (i & 3); }

struct Unit { int pm, pn; };
struct Gemm { const bf16_t* A; const bf16_t* Bt; int M, N, K; };

struct StaticOrder {
    int nM, nN, nwg, G, c;
    __host__ __device__ void init(int M, int N, int G_, int c_) { nM = M / BM; nN = N / BM; nwg = nM * nN; G = G_; c = c_; }
    __host__ __device__ bool next(int i, Unit& u) const {
        const long L = (long)i * G + c; if (L >= nwg) return false;
        int wgid = (int)L; { const int q = nwg / NXCD, r = nwg % NXCD, xcd = wgid % NXCD, off = wgid / NXCD; wgid = (xcd < r ? xcd * (q + 1) : r * (q + 1) + (xcd - r) * q) + off; }
        const int nig = WGM * nN, gid = wgid / nig, fm = gid * WGM, gsz = (nM - fm) < WGM ? (nM - fm) : WGM;
        u.pm = fm + ((wgid % nig) % gsz); u.pn = (wgid % nig) / gsz; return true;
    }
    __device__ __forceinline__ void a_ready(const Unit&) const {}
    __device__ __forceinline__ void done(const Unit&) const {}
};
__device__ __forceinline__ unsigned cvt_pk_bf16(float lo, float hi) { typedef float f2_ __attribute__((ext_vector_type(2))); typedef __bf16 b2_ __attribute__((ext_vector_type(2)));
    f2_ v = {lo, hi}; b2_ r = __builtin_convertvector(v, b2_); return __builtin_bit_cast(unsigned, r); }
template <class Epi, class Sched, bool ALIGN_EPI = false, bool SP2 = false>
__device__ __forceinline__ void gemm_phase(PG8_LAS unsigned char* lds, const Gemm g, const Sched& S, const Epi& E) {
    int tid_o = threadIdx.x; asm volatile("" : "+v"(tid_o));
    const int tid = tid_o, wid = __builtin_amdgcn_readfirstlane(tid >> 6), lane = tid & 63, wr = wid >> 2, wc = wid & 3, fr = lane & 15, fq = lane >> 4;
    const int K = g.K, nt = K / BK;
    unsigned voffA[2], voffB[2];
#pragma unroll
    for (int i = 0; i < 2; ++i) { int R, C; stage_rc(tid * 16 + i * 8192, R, C); const int Rb = Epi::PERM ? ((R & ~31) + perm32(R & 31)) : R;
        voffA[i] = (unsigned)(R * K + C) * 2u; voffB[i] = (unsigned)(Rb * K + C) * 2u; }
    const size_t kstep = (size_t)(BK * 2);
    const size_t hstep = (size_t)HALF * K * 2;
    const size_t tstep = 2 * hstep;
    const unsigned ldsw = (unsigned)wid * 1024u;
    const int aoff = lds_byte(wr * 64 + fr, fq * 8), boff = lds_byte(wc * 32 + fr, fq * 8);
#define PG8_SA(b, h) (((b) * 2 + (h)) * HTB)
#define PG8_SB(b, h) ((4 + (b) * 2 + (h)) * HTB)
#define PG8_STAGE(bufoff, gbase, voff) do { _Pragma("unroll") for (int _i = 0; _i < 2; ++_i) \
        __builtin_amdgcn_global_load_lds((const unsigned*)((const char*)(gbase) + (voff)[_i]), (PG8_LAS unsigned*)(lds + (bufoff) + ldsw + _i * 8192), 16, 0, 0); } while (0)
#define PG8_LDA(dst, b, h) do { _Pragma("unroll") for (int m = 0; m < 4; ++m) _Pragma("unroll") for (int k = 0; k < 2; ++k) dst[m][k] = *(const PG8_LAS bf16x8*)(lds + PG8_SA(b, h) + aoff + m * 2048 + k * 1024); } while (0)
#define PG8_LDB(dst, b, h) do { _Pragma("unroll") for (int n = 0; n < 2; ++n) _Pragma("unroll") for (int k = 0; k < 2; ++k) dst[n][k] = *(const PG8_LAS bf16x8*)(lds + PG8_SB(b, h) + boff + n * 2048 + k * 1024); } while (0)
#define PG8_MMA(ai, bj, At, Bt) do { __builtin_amdgcn_s_setprio(1); _Pragma("unroll") for (int m = 0; m < 4; ++m) _Pragma("unroll") for (int n = 0; n < 2; ++n) _Pragma("unroll") for (int k = 0; k < 2; ++k) \
        acc[ai][bj][m][n] = __builtin_amdgcn_mfma_f32_16x16x32_bf16(Bt[n][k], At[m][k], acc[ai][bj][m][n], 0, 0, 0); __builtin_amdgcn_s_setprio(0); } while (0)
#define PG8_WAIT_V(n) asm volatile("s_waitcnt vmcnt(" #n ")" ::: "memory")
#define PG8_WAIT_L(n) asm volatile("s_waitcnt lgkmcnt(" #n ")" ::: "memory")
#define PG8_BAR __builtin_amdgcn_s_barrier()
#define PG8_SCHED __builtin_amdgcn_sched_barrier(0)
    Unit cur, nxt; int ui = 0;
    if (!S.next(0, cur)) return;
    f32x4 acc[2][2][4][2];
#pragma unroll
    for (int a = 0; a < 2; ++a)
#pragma unroll
        for (int b = 0; b < 2; ++b)
#pragma unroll
            for (int m = 0; m < 4; ++m)
#pragma unroll
                for (int n = 0; n < 2; ++n) acc[a][b][m][n] = (f32x4){0.f, 0.f, 0.f, 0.f};
    bf16x8 At[4][2], B0[2][2], B1[2][2];
    const char* cA = (const char*)g.A + (size_t)cur.pm * tstep; const char* cB = (const char*)g.Bt + (size_t)cur.pn * tstep;
    S.a_ready(cur);
    if constexpr (SP2) {
        PG8_STAGE(PG8_SB(0, 0), cB, voffB); PG8_STAGE(PG8_SB(0, 1), cB + hstep, voffB); PG8_STAGE(PG8_SA(0, 0), cA, voffA); PG8_STAGE(PG8_SA(0, 1), cA + hstep, voffA);
        if (wr == 1) PG8_BAR;
        PG8_WAIT_V(2); PG8_BAR;
        PG8_STAGE(PG8_SB(1, 0), cB + kstep, voffB); PG8_STAGE(PG8_SA(1, 0), cA + kstep, voffA); PG8_STAGE(PG8_SB(1, 1), cB + hstep + kstep, voffB);
        PG8_WAIT_V(6); PG8_BAR;
    } else {
        PG8_STAGE(PG8_SB(0, 0), cB, voffB); PG8_STAGE(PG8_SA(0, 0), cA, voffA); PG8_STAGE(PG8_SB(0, 1), cB + hstep, voffB); PG8_STAGE(PG8_SA(0, 1), cA + hstep, voffA);
        if (wr == 1) PG8_BAR;
        PG8_WAIT_V(4); PG8_BAR;
        PG8_STAGE(PG8_SB(1, 0), cB + kstep, voffB); PG8_STAGE(PG8_SA(1, 0), cA + kstep, voffA); PG8_STAGE(PG8_SB(1, 1), cB + hstep + kstep, voffB);
        PG8_WAIT_V(6); PG8_BAR;
    }
    for (;;) {
        const bool has_next = S.next(ui + 1, nxt);
        const char* nA = has_next ? (const char*)g.A + (size_t)nxt.pm * tstep : cA; const char* nB = has_next ? (const char*)g.Bt + (size_t)nxt.pn * tstep : cB;
        for (int t = 0; t < nt; t += 2) {
            const bool last = (t == nt - 2);
            const char* a1 = cA + (size_t)(t + 1) * kstep;
            const char* a2 = last ? nA : cA + (size_t)(t + 2) * kstep; const char* b2 = last ? nB : cB + (size_t)(t + 2) * kstep;
            const char* a3 = a2 + kstep; const char* b3 = b2 + kstep;
            if (last && has_next) S.a_ready(nxt);
            if constexpr (SP2) {
            PG8_LDB(B0, 0, 0); PG8_LDB(B1, 0, 1); PG8_SCHED; PG8_LDA(At, 0, 0); PG8_STAGE(PG8_SA(1, 1), a1 + hstep, voffA);
            PG8_WAIT_V(8); PG8_WAIT_L(0); PG8_BAR; PG8_MMA(0, 0, At, B0); PG8_MMA(0, 1, At, B1); PG8_BAR; PG8_SCHED;
            PG8_LDA(At, 0, 1); PG8_STAGE(PG8_SB(0, 0), b2, voffB); PG8_STAGE(PG8_SB(0, 1), b2 + hstep, voffB); PG8_STAGE(PG8_SA(0, 0), a2, voffA);
            PG8_WAIT_V(8); PG8_WAIT_L(0); PG8_BAR; PG8_MMA(1, 0, At, B0); PG8_MMA(1, 1, At, B1); PG8_BAR; PG8_SCHED;
            PG8_LDB(B0, 1, 0); PG8_LDB(B1, 1, 1); PG8_SCHED; PG8_LDA(At, 1, 0); PG8_STAGE(PG8_SA(0, 1), a2 + hstep, voffA);
            PG8_WAIT_V(8); PG8_WAIT_L(0); PG8_BAR; PG8_MMA(0, 0, At, B0); PG8_MMA(0, 1, At, B1); PG8_BAR; PG8_SCHED;
            PG8_LDA(At, 1, 1); PG8_STAGE(PG8_SB(1, 0), b3, voffB); PG8_STAGE(PG8_SB(1, 1), b3 + hstep, voffB); PG8_STAGE(PG8_SA(1, 0), a3, voffA);
            PG8_WAIT_V(8); PG8_WAIT_L(0); PG8_BAR; PG8_MMA(1, 0, At, B0); PG8_MMA(1, 1, At, B1); PG8_BAR; PG8_SCHED;
            } else {
            PG8_LDB(B0, 0, 0); PG8_SCHED; PG8_LDA(At, 0, 0); PG8_STAGE(PG8_SA(1, 1), a1 + hstep, voffA);
            PG8_WAIT_L(8); PG8_BAR; PG8_WAIT_L(0); PG8_MMA(0, 0, At, B0); PG8_BAR; PG8_SCHED;
            PG8_LDB(B1, 0, 1); PG8_STAGE(PG8_SB(0, 0), b2, voffB);
            PG8_BAR; PG8_WAIT_L(0); PG8_MMA(0, 1, At, B1); PG8_BAR;
            PG8_LDA(At, 0, 1); PG8_STAGE(PG8_SA(0, 0), a2, voffA);
            PG8_BAR; PG8_WAIT_L(0); PG8_MMA(1, 0, At, B0); PG8_BAR; PG8_SCHED;
            PG8_STAGE(PG8_SB(0, 1), b2 + hstep, voffB);
            PG8_WAIT_V(6); PG8_BAR; PG8_MMA(1, 1, At, B1); PG8_BAR;
            PG8_LDB(B0, 1, 0); PG8_SCHED; PG8_LDA(At, 1, 0); PG8_STAGE(PG8_SA(0, 1), a2 + hstep, voffA);
            PG8_WAIT_L(8); PG8_BAR; PG8_WAIT_L(0); PG8_MMA(0, 0, At, B0); PG8_BAR; PG8_SCHED;
            PG8_LDB(B1, 1, 1); PG8_STAGE(PG8_SB(1, 0), b3, voffB);
            PG8_BAR; PG8_WAIT_L(0); PG8_MMA(0, 1, At, B1); PG8_BAR;
            PG8_LDA(At, 1, 1); PG8_STAGE(PG8_SA(1, 0), a3, voffA);
            PG8_BAR; PG8_WAIT_L(0); PG8_MMA(1, 0, At, B0); PG8_BAR; PG8_SCHED;
            PG8_STAGE(PG8_SB(1, 1), b3 + hstep, voffB);
            PG8_WAIT_V(6); PG8_BAR; PG8_MMA(1, 1, At, B1); PG8_BAR;
            }
        }
        if constexpr (ALIGN_EPI) { if (wr == 0) PG8_BAR; }
        if constexpr (!Epi::AFTER_DRAIN) { E(acc, cur, wr, wc, fr, fq); S.done(cur); }
        if (!has_next) break;
#pragma unroll
        for (int a = 0; a < 2; ++a)
#pragma unroll
            for (int b = 0; b < 2; ++b)
#pragma unroll
                for (int m = 0; m < 4; ++m)
#pragma unroll
                    for (int n = 0; n < 2; ++n) acc[a][b][m][n] = (f32x4){0.f, 0.f, 0.f, 0.f};
        cur = nxt; cA = nA; cB = nB; ++ui;
        if constexpr (ALIGN_EPI) { if (wr == 1) PG8_BAR; }
    }
    PG8_WAIT_V(0);
    if constexpr (!ALIGN_EPI) { if (wr == 0) PG8_BAR; }
    PG8_BAR;
    if constexpr (Epi::AFTER_DRAIN) { E.fused(acc, cur, wr, wc, fr, fq, lds, wid, lane); S.done(cur); }
#undef PG8_SA
#undef PG8_SB
#undef PG8_STAGE
#undef PG8_LDA
#undef PG8_LDB
#undef PG8_MMA
#undef PG8_WAIT_V
#undef PG8_WAIT_L
#undef PG8_BAR
#undef PG8_SCHED
}
}

#define LAS __attribute__((address_space(3)))
typedef unsigned short bf16_t;
typedef short bf16x8 __attribute__((ext_vector_type(8)));
typedef short bf16x4 __attribute__((ext_vector_type(4)));
typedef float f32x4 __attribute__((ext_vector_type(4)));
typedef unsigned u32x4 __attribute__((ext_vector_type(4)));
typedef unsigned u32x2 __attribute__((ext_vector_type(2)));
typedef float f32x2_t __attribute__((ext_vector_type(2)));
constexpr int T = 32768, D = 1024, FF = 2816, NFF2 = 5632, SEQ = 4096, NMOD = 9216, INC = 6416;
constexpr int NA = 2304, NAG = 2560, NBG = 4096, NB = 3584;
constexpr float EPS = 1e-6f;
constexpr size_t MiB = 1u << 20;
constexpr size_t WS_CTL = 0, CTL_BYTES = 65536;
constexpr size_t WS_MOD = 65536;
constexpr size_t WS_W = 1 * MiB, WS_WSTRIDE = 49 * MiB;
constexpr size_t W_1IN = 0, W_1OUT = W_1IN + (size_t)NFF2 * D * 2, W_A = W_1OUT + (size_t)D * FF * 2, W_B = W_A + (size_t)NAG * D * 2,
                 W_O = W_B + (size_t)NBG * D * 2, W_2IN = W_O + (size_t)D * D * 2, W_2OUT = W_2IN + (size_t)NFF2 * D * 2, W_END = W_2OUT + (size_t)D * FF * 2;
static_assert(W_END <= 49 * MiB, "weights");
constexpr size_t WS_H = 99 * MiB;
constexpr size_t WS_MRG = 163 * MiB;
constexpr size_t WS_PROJ = 227 * MiB;
static_assert((size_t)T * NB * 2 <= 224 * MiB && (size_t)T * FF * 2 <= 224 * MiB && (size_t)T * NA * 2 <= 224 * MiB, "PROJ region = 224 MiB");
constexpr size_t WS_LR = 451 * MiB;
constexpr int LDS_BYTES = 147456;

__device__ __forceinline__ float bf2f(unsigned v) { return __uint_as_float(v << 16); }
__device__ __forceinline__ float bflo(unsigned v) { return __uint_as_float(v << 16); }
__device__ __forceinline__ float bfhi(unsigned v) { return __uint_as_float(v & 0xffff0000u); }
__device__ __forceinline__ float wave_sum(float v) {
#pragma unroll
    for (int o = 1; o < 64; o <<= 1) v += __shfl_xor(v, o);
    return v;
}
__device__ __forceinline__ float sigm(float v) { return __builtin_amdgcn_rcpf(1.f + __expf(-v)); }
__device__ __forceinline__ f32x4 mfma16(bf16x8 a, bf16x8 b, f32x4 c) { return __builtin_amdgcn_mfma_f32_16x16x32_bf16(a, b, c, 0, 0, 0); }

__device__ __forceinline__ int otid() { int t = threadIdx.x; asm volatile("" : "+v"(t)); return t; }
using pg8::Unit;
struct EpiSwiGLU {
    static constexpr bool PERM = true, AFTER_DRAIN = false;
    bf16_t* O;
    __device__ __forceinline__ void operator()(const f32x4 (&acc)[2][2][4][2], const Unit& u, int wr, int wc, int fr, int fq) const {
        const int row0 = u.pm * 256 + wr * 64 + fr, col0 = u.pn * 128 + wc * 32 + 8 * fq;
#pragma unroll
        for (int ai = 0; ai < 2; ++ai)
#pragma unroll
            for (int m = 0; m < 4; ++m) {
                bf16_t* rowp = O + (size_t)(row0 + ai * 128 + m * 16) * FF + col0;
                float v[8];
#pragma unroll
                for (int n = 0; n < 2; ++n)
#pragma unroll
                    for (int j = 0; j < 4; ++j) { const float g = acc[ai][0][m][n][j], up = acc[ai][1][m][n][j]; v[n * 4 + j] = g * sigm(g) * up; }
                u32x4 w; w.x = pg8::cvt_pk_bf16(v[0], v[1]); w.y = pg8::cvt_pk_bf16(v[2], v[3]); w.z = pg8::cvt_pk_bf16(v[4], v[5]); w.w = pg8::cvt_pk_bf16(v[6], v[7]);
                *(u32x4*)rowp = w;
            }
    }
};
struct EpiResid {
    static constexpr bool PERM = true, AFTER_DRAIN = false;
    bf16_t* Dl; const float* gate; float coef;
    __device__ __forceinline__ void operator()(const f32x4 (&acc)[2][2][4][2], const Unit& u, int wr, int wc, int fr, int fq) const {
        const int row0 = u.pm * 256 + wr * 64 + fr, b = u.pm >> 4;
#pragma unroll
        for (int bj = 0; bj < 2; ++bj) {
            const int col0 = u.pn * 256 + bj * 128 + wc * 32 + 8 * fq;
            const f32x4 g0 = *(const f32x4*)(gate + (size_t)b * NMOD + col0) * coef, g1 = *(const f32x4*)(gate + (size_t)b * NMOD + col0 + 4) * coef;
#pragma unroll
            for (int ai = 0; ai < 2; ++ai)
#pragma unroll
                for (int m = 0; m < 4; ++m) { const f32x4 v0 = acc[ai][bj][m][0] * g0, v1 = acc[ai][bj][m][1] * g1;
                    u32x4 w; w.x = pg8::cvt_pk_bf16(v0[0], v0[1]); w.y = pg8::cvt_pk_bf16(v0[2], v0[3]); w.z = pg8::cvt_pk_bf16(v1[0], v1[1]); w.w = pg8::cvt_pk_bf16(v1[2], v1[3]);
                    *(u32x4*)(Dl + (size_t)(row0 + ai * 128 + m * 16) * D + col0) = w; }
        }
    }
};
struct EpiProj {
    static constexpr bool PERM = true, AFTER_DRAIN = false;
    bf16_t* O; int ldc; int mode; float* LR;
    __device__ __forceinline__ void operator()(const f32x4 (&acc)[2][2][4][2], const Unit& u, int wr, int wc, int fr, int fq) const {
        const int row0 = u.pm * 256 + wr * 64 + fr;
        if (mode == 0 && u.pn == 9) {
            if (wc == 0 && fq < 2) {
#pragma unroll
                for (int ai = 0; ai < 2; ++ai)
#pragma unroll
                    for (int m = 0; m < 4; ++m) { float* lp = LR + (size_t)(row0 + ai * 128 + m * 16) * 16 + 8 * fq; *(f32x4*)lp = acc[ai][0][m][0]; *(f32x4*)(lp + 4) = acc[ai][0][m][1]; }
            }
            return;
        }
        if (mode == 1 && u.pn >= 8 && u.pn < 16) {
            const int col0 = 2048 + 128 * (u.pn - 8) + wc * 32 + 8 * fq;
#pragma unroll
            for (int ai = 0; ai < 2; ++ai)
#pragma unroll
                for (int m = 0; m < 4; ++m) {
                    float v[8];
#pragma unroll
                    for (int n = 0; n < 2; ++n)
#pragma unroll
                        for (int j = 0; j < 4; ++j) { const float r_ = acc[ai][0][m][n][j], g_ = acc[ai][1][m][n][j]; v[n * 4 + j] = r_ * sigm(r_) * sigm(g_); }
                    u32x4 w; w.x = pg8::cvt_pk_bf16(v[0], v[1]); w.y = pg8::cvt_pk_bf16(v[2], v[3]); w.z = pg8::cvt_pk_bf16(v[4], v[5]); w.w = pg8::cvt_pk_bf16(v[6], v[7]);
                    *(u32x4*)(O + (size_t)(row0 + ai * 128 + m * 16) * ldc + col0) = w;
                }
            return;
        }
#pragma unroll
        for (int bj = 0; bj < 2; ++bj) {
            const int c0 = u.pn * 256 + bj * 128;
            int code, oc0 = c0; float sc = 1.f;
            if (mode == 0) { if (c0 < 1024) { code = 0; sc = 0.125f; } else if (c0 < 1280) code = 0; else code = 1; }
            else { code = 0; if (c0 < 512) sc = 0.08838834764831845f; }
            const int col0 = oc0 + wc * 32 + 8 * fq;
#pragma unroll
            for (int ai = 0; ai < 2; ++ai)
#pragma unroll
                for (int m = 0; m < 4; ++m) {
                    float v[8];
#pragma unroll
                    for (int n = 0; n < 2; ++n)
#pragma unroll
                        for (int j = 0; j < 4; ++j) { float x = acc[ai][bj][m][n][j];
                            if (code == 0) x = x * sc;
                            else x = sigm(x);
                            v[n * 4 + j] = x; }
                    u32x4 w; w.x = pg8::cvt_pk_bf16(v[0], v[1]); w.y = pg8::cvt_pk_bf16(v[2], v[3]); w.z = pg8::cvt_pk_bf16(v[4], v[5]); w.w = pg8::cvt_pk_bf16(v[6], v[7]);
                    *(u32x4*)(O + (size_t)(row0 + ai * 128 + m * 16) * ldc + col0) = w;
                }
        }
    }
};

__device__ __forceinline__ void transpose_item(const float* W, int Nsrc, int K, bf16_t* WT, int k0, int srccol0, int dstrow0, LAS float* scr, int lane) {
#pragma unroll 8
    for (int i = 0; i < 32; ++i) { const int kk = 2 * i + (lane >> 5); scr[kk * 33 + (lane & 31)] = W[(size_t)(k0 + kk) * Nsrc + srccol0 + (lane & 31)]; }
    asm volatile("s_waitcnt lgkmcnt(0)" ::: "memory");
    const int c = lane & 7;
#pragma unroll
    for (int j = 0; j < 4; ++j) { const int n = (lane >> 3) + 8 * j; const LAS float* s = scr + (8 * c) * 33 + n;
        u32x4 o; o.x = pg8::cvt_pk_bf16(s[0 * 33], s[1 * 33]); o.y = pg8::cvt_pk_bf16(s[2 * 33], s[3 * 33]); o.z = pg8::cvt_pk_bf16(s[4 * 33], s[5 * 33]); o.w = pg8::cvt_pk_bf16(s[6 * 33], s[7 * 33]);
        *(u32x4*)(WT + (size_t)(dstrow0 + n) * K + k0 + 8 * c) = o; }
    asm volatile("s_waitcnt lgkmcnt(0)" ::: "memory");
}
__device__ __forceinline__ int map_src(int mapid, int r) {
    if (mapid == 1) { const int pn = r >> 8, bj = (r >> 7) & 1, j = r & 127; return bj * FF + 128 * pn + j; }
    if (mapid == 2) return r < 1280 ? r : (r < 2304 ? r + 3088 : 3328 + (r - 2304));
    if (mapid == 3) { if (r < 2048) return r + 1280; const int rr = r - 2048, t = rr >> 8, bj = (rr >> 7) & 1, j = rr & 127; return (bj ? 5392 : 3344) + 128 * t + j; }
    return r;
}
struct ConvItem { const float* W; bf16_t* WT; int Nsrc, K, k0, srccol0, dstrow0; };
__device__ __forceinline__ void tr_load(const ConvItem& ci, int lane, float (&tv)[32]) {
#pragma unroll
    for (int i = 0; i < 32; ++i) { const int kk = 2 * i + (lane >> 5); tv[i] = ci.W[(size_t)(ci.k0 + kk) * ci.Nsrc + ci.srccol0 + (lane & 31)]; }
}
__device__ __forceinline__ void tr_finish(const ConvItem& ci, int lane, const float (&tv)[32], LAS float* scr) {
#pragma unroll
    for (int i = 0; i < 32; ++i) { const int kk = 2 * i + (lane >> 5); scr[kk * 33 + (lane & 31)] = tv[i]; }
    asm volatile("s_waitcnt lgkmcnt(0)" ::: "memory");
    const int c = lane & 7;
#pragma unroll
    for (int j = 0; j < 4; ++j) { const int n = (lane >> 3) + 8 * j; const LAS float* s = scr + (8 * c) * 33 + n;
        u32x4 o; o.x = pg8::cvt_pk_bf16(s[0 * 33], s[1 * 33]); o.y = pg8::cvt_pk_bf16(s[2 * 33], s[3 * 33]); o.z = pg8::cvt_pk_bf16(s[4 * 33], s[5 * 33]); o.w = pg8::cvt_pk_bf16(s[6 * 33], s[7 * 33]);
        *(u32x4*)(ci.WT + (size_t)(ci.dstrow0 + n) * ci.K + ci.k0 + 8 * c) = o; }
    asm volatile("s_waitcnt lgkmcnt(0)" ::: "memory");
}
__device__ __forceinline__ bool conv_try(int& it, const float* W, int Nsrc, int K, bf16_t* WT, int ndst, int mapid, LAS float* scr, int lane) {
    const int ng = ndst / 32, n = (K / 64) * ng;
    if (it >= n) { it -= n; return false; }
    const int kb = it / ng, g = it % ng;
    transpose_item(W, Nsrc, K, WT, 64 * kb, map_src(mapid, 32 * g), 32 * g, scr, lane);
    return true;
}
struct LayerW { const float *f1in, *f1out, *mixin, *wgate, *mixout, *f2in, *f2out; };
constexpr int CONV_NITEMS = 2 * (16 * 176) + 2 * (44 * 32) + 16 * 80 + 16 * 128 + 16 * 32;
__device__ __forceinline__ bool conv_pick(int& it, const float* W, int Nsrc, int K, bf16_t* WT, int ndst, int mapid, ConvItem& ci) {
    const int ng = ndst / 32, n = (K / 64) * ng;
    if (it >= n) { it -= n; return false; }
    const int kb = it / ng, g = it % ng;
    ci.W = W; ci.WT = WT; ci.Nsrc = Nsrc; ci.K = K; ci.k0 = 64 * kb; ci.srccol0 = map_src(mapid, 32 * g); ci.dstrow0 = 32 * g; return true;
}
constexpr int CONV_LATE = 16 * 176 + 44 * 32 + 16 * 32;
__device__ __forceinline__ ConvItem conv_decode_late(int it, const LayerW& L, unsigned char* wsw) {
    ConvItem ci;
    if (conv_pick(it, L.f2in, NFF2, D, (bf16_t*)(wsw + W_2IN), NFF2, 1, ci)) return ci;
    if (conv_pick(it, L.f2out, D, FF, (bf16_t*)(wsw + W_2OUT), D, 0, ci)) return ci;
    conv_pick(it, L.mixout, D, D, (bf16_t*)(wsw + W_O), D, 0, ci); return ci;
}
__device__ __forceinline__ ConvItem conv_decode(int it, const LayerW& L, unsigned char* wsw) {
    ConvItem ci;
    if (conv_pick(it, L.f1in, NFF2, D, (bf16_t*)(wsw + W_1IN), NFF2, 1, ci)) return ci;
    if (conv_pick(it, L.f2in, NFF2, D, (bf16_t*)(wsw + W_2IN), NFF2, 1, ci)) return ci;
    if (conv_pick(it, L.f1out, D, FF, (bf16_t*)(wsw + W_1OUT), D, 0, ci)) return ci;
    if (conv_pick(it, L.f2out, D, FF, (bf16_t*)(wsw + W_2OUT), D, 0, ci)) return ci;
    if (conv_pick(it, L.mixin, INC, D, (bf16_t*)(wsw + W_A), NAG, 2, ci)) return ci;
    if (conv_pick(it, L.mixin, INC, D, (bf16_t*)(wsw + W_B), 4096, 3, ci)) return ci;
    conv_pick(it, L.mixout, D, D, (bf16_t*)(wsw + W_O), D, 0, ci); return ci;
}
__device__ __forceinline__ void wconv_phase(LAS unsigned char* lds, const LayerW& L, unsigned char* wsw, int vwg, int G) {
    const int tid = otid(), lane = tid & 63, wave = __builtin_amdgcn_readfirstlane(tid >> 6);
    LAS float* scr = (LAS float*)(lds + wave * 8704);
    const int gw = vwg * 8 + wave, NGW = G * 8;
    constexpr int NITEMS = 16 * 176 + 44 * 32 + 16 * 80 + 16 * 128;
    for (int it0 = gw; it0 < NITEMS; it0 += NGW) {
        int it = it0;
        if (conv_try(it, L.f1in, NFF2, D, (bf16_t*)(wsw + W_1IN), NFF2, 1, scr, lane)) continue;
        if (conv_try(it, L.f1out, D, FF, (bf16_t*)(wsw + W_1OUT), D, 0, scr, lane)) continue;
        if (conv_try(it, L.mixin, INC, D, (bf16_t*)(wsw + W_A), NAG, 2, scr, lane)) continue;
        conv_try(it, L.mixin, INC, D, (bf16_t*)(wsw + W_B), 4096, 3, scr, lane);
    }
}
__device__ __forceinline__ void mod_phase(LAS unsigned char* lds, const float* c, const float* ada_w, const float* ada_b, float* MOD, int vwg, int G) {
    const int tid = otid(), lane = tid & 63, wave = __builtin_amdgcn_readfirstlane(tid >> 6);
    LAS float* cond = (LAS float*)lds;
    LAS float* red = (LAS float*)(lds + 32768);
    for (int i = tid; i < 8 * D; i += 512) { const float v = c[i]; cond[i] = v * sigm(v); }
    __syncthreads();
    for (int item = vwg; item < 2 * (NMOD / 64); item += G) {
        const int l = item / (NMOD / 64), n0 = (item % (NMOD / 64)) * 64;
        const float* wp = ada_w + (size_t)l * D * NMOD + (size_t)(wave * 128) * NMOD + n0 + lane;
        float acc[8];
#pragma unroll
        for (int b = 0; b < 8; ++b) acc[b] = 0.f;
        for (int k4 = 0; k4 < 32; ++k4) {
            float wv[4];
#pragma unroll
            for (int j = 0; j < 4; ++j) wv[j] = wp[(size_t)(k4 * 4 + j) * NMOD];
#pragma unroll
            for (int b = 0; b < 8; ++b) { const f32x4 cv = *(const LAS f32x4*)(cond + b * D + wave * 128 + k4 * 4); acc[b] += cv[0] * wv[0] + cv[1] * wv[1] + cv[2] * wv[2] + cv[3] * wv[3]; }
        }
#pragma unroll
        for (int b = 0; b < 8; ++b) red[(wave * 8 + b) * 64 + lane] = acc[b];
        __syncthreads();
        { const int b = tid >> 6; float s = ada_b[(size_t)l * NMOD + n0 + lane];
#pragma unroll
          for (int w = 0; w < 8; ++w) s += red[(w * 8 + b) * 64 + lane];
          MOD[((size_t)l * 8 + b) * NMOD + n0 + lane] = s; }
        __syncthreads();
    }
}

__device__ __forceinline__ void norm_phase(const float* Xin, float* Xout, bf16_t* H, int has_delta, const float* gain, const float* shift, const float* scale, int vwg, int G) {
    const int tid_ = otid(), lane = tid_ & 63, wave = __builtin_amdgcn_readfirstlane(tid_ >> 6);
    for (int rg = vwg * 8 + wave; rg < T / 16; rg += G * 8) {
        const int row0 = rg * 16, b = row0 / SEQ;
        f32x4 A[4], Bs[4];
#pragma unroll
        for (int j = 0; j < 4; ++j) { const int cidx = 4 * lane + 256 * j; const f32x4 g = *(const f32x4*)(gain + cidx), sc = *(const f32x4*)(scale + (size_t)b * NMOD + cidx);
            A[j] = g * (sc + 1.0f); Bs[j] = *(const f32x4*)(shift + (size_t)b * NMOD + cidx); }
        f32x4 nx[4]; u32x2 nd[4];
        { const f32x4* xr = (const f32x4*)(Xin + (size_t)row0 * D) + lane; const u32x2* dr = (const u32x2*)(H + (size_t)row0 * D) + lane;
#pragma unroll
          for (int j = 0; j < 4; ++j) { nx[j] = xr[64 * j]; nd[j] = has_delta ? dr[64 * j] : (u32x2){0u, 0u}; } }
        for (int r = 0; r < 16; ++r) {
            u32x2* o8 = (u32x2*)(H + (size_t)(row0 + r) * D) + lane;
            f32x4 v[4]; float s = 0.f;
#pragma unroll
            for (int j = 0; j < 4; ++j) { v[j] = nx[j] + (f32x4){bflo(nd[j].x), bfhi(nd[j].x), bflo(nd[j].y), bfhi(nd[j].y)};
                s += (v[j][0] * v[j][0] + v[j][1] * v[j][1]) + (v[j][2] * v[j][2] + v[j][3] * v[j][3]); }
            if (r + 1 < 16) { const f32x4* xr = (const f32x4*)(Xin + (size_t)(row0 + r + 1) * D) + lane; const u32x2* dr = (const u32x2*)(H + (size_t)(row0 + r + 1) * D) + lane;
#pragma unroll
                for (int j = 0; j < 4; ++j) { nx[j] = xr[64 * j]; nd[j] = has_delta ? dr[64 * j] : (u32x2){0u, 0u}; } }
            if (has_delta) { f32x4* xo = (f32x4*)(Xout + (size_t)(row0 + r) * D) + lane;
#pragma unroll
                for (int j = 0; j < 4; ++j) xo[64 * j] = v[j]; }
            const float rstd = 1.0f / sqrtf(wave_sum(s) * (1.f / D) + EPS);
#pragma unroll
            for (int j = 0; j < 4; ++j) { const f32x4 y = (v[j] * rstd) * A[j] + Bs[j]; u32x2 w; w.x = pg8::cvt_pk_bf16(y[0], y[1]); w.y = pg8::cvt_pk_bf16(y[2], y[3]); o8[64 * j] = w; }
        }
    }
}
__device__ __forceinline__ void final_norm_phase(float* X, const bf16_t* H, const float* gain, int vwg, int G) {
    const int tid_ = otid(), lane = tid_ & 63, wave = __builtin_amdgcn_readfirstlane(tid_ >> 6);
    f32x4 A[4];
#pragma unroll
    for (int j = 0; j < 4; ++j) A[j] = *(const f32x4*)(gain + 4 * lane + 256 * j);
    for (int row = vwg * 8 + wave; row < T; row += G * 8) {
        f32x4* xr = (f32x4*)(X + (size_t)row * D) + lane; const u32x2* dr = (const u32x2*)(H + (size_t)row * D) + lane;
        f32x4 v[4]; float s = 0.f;
#pragma unroll
        for (int j = 0; j < 4; ++j) { const u32x2 d = dr[64 * j]; v[j] = xr[64 * j] + (f32x4){bflo(d.x), bfhi(d.x), bflo(d.y), bfhi(d.y)}; s += (v[j][0] * v[j][0] + v[j][1] * v[j][1]) + (v[j][2] * v[j][2] + v[j][3] * v[j][3]); }
        const float rstd = 1.0f / sqrtf(wave_sum(s) * (1.f / D) + EPS);
#pragma unroll
        for (int j = 0; j < 4; ++j) xr[64 * j] = (v[j] * rstd) * A[j];
    }
}

__device__ __forceinline__ __amdgpu_buffer_rsrc_t mk_rsrc(const void* p) { return __builtin_amdgcn_make_buffer_rsrc((void*)p, 0, 0x7fffffff, 0x00020000); }
__device__ __forceinline__ void att_phase(LAS unsigned char* lds, const bf16_t* PA, bf16_t* MRG, const float* sinks, int vwg, int G, int do_conv, const LayerW& Lc, unsigned char* wswc, const LayerW& Ln, unsigned char* wswn) {
    const int tid = otid(), lane = tid & 63, w = __builtin_amdgcn_readfirstlane(tid >> 6), lr = lane & 15, lq = lane >> 4;
    LAS unsigned char* Kimg = lds;
    LAS unsigned char* VT = lds + 36864;
    const __amdgpu_buffer_rsrc_t rPA = mk_rsrc(PA), rMR = mk_rsrc(MRG);
    const unsigned qvo = ((unsigned)lr * NA + 8u * lq) * 2u;
    const unsigned gvo = ((unsigned)lr * NA + 4u * lq) * 2u;
    const unsigned ovo = ((unsigned)lr * D + 4u * lq) * 2u;
    for (int e = tid; e < 64 * 16; e += 512) *(LAS bf16_t*)(VT + (e >> 4) * 560 + (256 + (e & 15)) * 2) = 0;
    LAS float* cscr = (LAS float*)(lds + 72704 + w * 8448);
    const int cgw = vwg * 8 + w, cNGW = G * 8; int cslot = 0;
    for (int item = vwg; item < 512; item += G) {
        const int g = item & 1, nbk = (item >> 1) & 31, b = item >> 6;
        const int t0 = b * SEQ + nbk * 128;
        const int hq = 8 * g + w;
        u32x4 qn0 = __builtin_amdgcn_raw_buffer_load_b128(rPA, qvo, (t0 * NA + hq * 64) * 2, 0), qn1 = __builtin_amdgcn_raw_buffer_load_b128(rPA, qvo, (t0 * NA + hq * 64 + 32) * 2, 0);
        u32x2 gn_[4];
#pragma unroll
        for (int dt = 0; dt < 4; ++dt) gn_[dt] = __builtin_amdgcn_raw_buffer_load_b64(rPA, gvo, (t0 * NA + 1280 + hq * 64 + 16 * dt) * 2, 0);
        __syncthreads();
#pragma unroll
        for (int c = 0; c < 4; ++c) {
            const int id = tid + 512 * c, row = id >> 3, piece = id & 7;
            u32x4 kv = {0u, 0u, 0u, 0u}, vv = {0u, 0u, 0u, 0u};
            if (nbk > 0 || row >= 128) { const bf16_t* p = PA + (size_t)(t0 - 128 + row) * NA + 1024 + 64 * g + 8 * piece; kv = *(const u32x4*)p; vv = *(const u32x4*)(p + 128); }
            *(LAS u32x4*)(Kimg + row * 144 + piece * 16) = kv;
            LAS bf16_t* vt = (LAS bf16_t*)VT + (8 * piece) * 280 + row;
            vt[0 * 280] = (bf16_t)(vv.x & 0xffffu); vt[1 * 280] = (bf16_t)(vv.x >> 16); vt[2 * 280] = (bf16_t)(vv.y & 0xffffu); vt[3 * 280] = (bf16_t)(vv.y >> 16);
            vt[4 * 280] = (bf16_t)(vv.z & 0xffffu); vt[5 * 280] = (bf16_t)(vv.z >> 16); vt[6 * 280] = (bf16_t)(vv.w & 0xffffu); vt[7 * 280] = (bf16_t)(vv.w >> 16);
        }
        __syncthreads();
        const float sink = sinks[hq];
        for (int mt = 0; mt < 8; ++mt) {
            const bf16x8 qf0 = __builtin_bit_cast(bf16x8, qn0), qf1 = __builtin_bit_cast(bf16x8, qn1);
            u32x2 gc[4];
#pragma unroll
            for (int dt = 0; dt < 4; ++dt) gc[dt] = gn_[dt];
            if (mt + 1 < 8) {
                const int tn = (t0 + 16 * (mt + 1)) * NA;
                qn0 = __builtin_amdgcn_raw_buffer_load_b128(rPA, qvo, (tn + hq * 64) * 2, 0); qn1 = __builtin_amdgcn_raw_buffer_load_b128(rPA, qvo, (tn + hq * 64 + 32) * 2, 0);
#pragma unroll
                for (int dt = 0; dt < 4; ++dt) gn_[dt] = __builtin_amdgcn_raw_buffer_load_b64(rPA, gvo, (tn + 1280 + hq * 64 + 16 * dt) * 2, 0);
            }
            const int cit = cgw + cslot * cNGW; const bool cdo = do_conv && cit < CONV_LATE + CONV_NITEMS;
            ConvItem ci; float tv[32];
            if (cdo) { ci = (cit < CONV_LATE) ? conv_decode_late(cit, Lc, wswc) : conv_decode(cit - CONV_LATE, Ln, wswn); tr_load(ci, lane, tv); }
            f32x4 s[9];
#pragma unroll
            for (int a = 0; a < 9; ++a) {
                const LAS unsigned char* kp = Kimg + (16 * (mt + a) + lr) * 144 + lq * 16;
                const bf16x8 k0 = *(const LAS bf16x8*)kp, k1 = *(const LAS bf16x8*)(kp + 64);
                f32x4 z = {0.f, 0.f, 0.f, 0.f};
                z = mfma16(k0, qf0, z); z = mfma16(k1, qf1, z); s[a] = z;
            }
            const int i = 16 * mt + lr;
            float mx = sink;
#pragma unroll
            for (int a = 0; a < 9; ++a)
#pragma unroll
                for (int r = 0; r < 4; ++r) { const int j = 16 * (mt + a) + 4 * lq + r, dd = j - i; const bool valid = (dd >= 1) && (dd <= 128) && (nbk > 0 || j >= 128);
                    const float v = valid ? s[a][r] : -INFINITY; s[a][r] = v; mx = fmaxf(mx, v); }
            mx = fmaxf(mx, __shfl_xor(mx, 16)); mx = fmaxf(mx, __shfl_xor(mx, 32));
            float sum = 0.f;
#pragma unroll
            for (int a = 0; a < 9; ++a)
#pragma unroll
                for (int r = 0; r < 4; ++r) { const float p = __expf(s[a][r] - mx); s[a][r] = p; sum += p; }
            sum += __shfl_xor(sum, 16); sum += __shfl_xor(sum, 32);
            const float inv = 1.0f / (sum + __expf(sink - mx));
            bf16x8 pf[5];
#pragma unroll
            for (int kk = 0; kk < 5; ++kk) {
                u32x4 wv; wv.x = pg8::cvt_pk_bf16(s[2 * kk][0] * inv, s[2 * kk][1] * inv); wv.y = pg8::cvt_pk_bf16(s[2 * kk][2] * inv, s[2 * kk][3] * inv);
                if (kk < 4) { wv.z = pg8::cvt_pk_bf16(s[2 * kk + 1][0] * inv, s[2 * kk + 1][1] * inv); wv.w = pg8::cvt_pk_bf16(s[2 * kk + 1][2] * inv, s[2 * kk + 1][3] * inv); } else { wv.z = 0u; wv.w = 0u; }
                pf[kk] = __builtin_bit_cast(bf16x8, wv);
            }
#pragma unroll
            for (int dt = 0; dt < 4; ++dt) {
                f32x4 o = {0.f, 0.f, 0.f, 0.f};
#pragma unroll
                for (int kk = 0; kk < 5; ++kk) {
                    const LAS unsigned char* vp = VT + (16 * dt + lr) * 560 + (16 * (mt + 2 * kk) + 4 * lq) * 2;
                    const bf16x4 v0 = *(const LAS bf16x4*)vp, v1 = *(const LAS bf16x4*)(vp + 32);
                    const bf16x8 vf = __builtin_shufflevector(v0, v1, 0, 1, 2, 3, 4, 5, 6, 7);
                    o = mfma16(vf, pf[kk], o);
                }
                const u32x2 ga = gc[dt];
                u32x2 ow; ow.x = pg8::cvt_pk_bf16(o[0] * bflo(ga.x), o[1] * bfhi(ga.x)); ow.y = pg8::cvt_pk_bf16(o[2] * bflo(ga.y), o[3] * bfhi(ga.y));
                __builtin_amdgcn_raw_buffer_store_b64(ow, rMR, ovo, ((t0 + 16 * mt) * D + hq * 64 + 16 * dt) * 2, 0);
            }
            if (cdo) tr_finish(ci, lane, tv, cscr);
            ++cslot;
        }
    }
    if (do_conv) {
        for (; cgw + cslot * cNGW < CONV_LATE + CONV_NITEMS; ++cslot) { const int cit = cgw + cslot * cNGW; float tv[32];
            const ConvItem ci = (cit < CONV_LATE) ? conv_decode_late(cit, Lc, wswc) : conv_decode(cit - CONV_LATE, Ln, wswn);
            tr_load(ci, lane, tv); tr_finish(ci, lane, tv, cscr); }
    }
}

#define LDS_BAR0() do { asm volatile("s_waitcnt lgkmcnt(0)" ::: "memory"); __builtin_amdgcn_s_barrier(); asm volatile("" ::: "memory"); } while (0)
constexpr int G2_QG = 0, G2_KR = 17408, G2_KGT = 34816, G2_VT = 53248, G2_AT = 90112, G2_DEC = 99328, G2_TOT = 99840, G2_RED = 103936, G2_DSG = 105984, G2_LRS = 110080;
template <int PASS>
__device__ __forceinline__ void gla2_phase(LAS unsigned char* lds, const bf16_t* PB, bf16_t* MRG, float* SLOC, float* DSEG, const float* gn, int vwg, int G, bf16_t* MRGO, const float* LRp, const float* wgp, const float* bgp) {
    const int tid = otid(), lane = tid & 63, w = __builtin_amdgcn_readfirstlane(tid >> 6), lr = lane & 15, lq = lane >> 4;
    LAS unsigned char *QG = lds + G2_QG, *KR = lds + G2_KR, *KGT = lds + G2_KGT, *VT = lds + G2_VT, *AT = lds + G2_AT;
    LAS float* DEC = (LAS float*)(lds + G2_DEC); LAS float* TOT = (LAS float*)(lds + G2_TOT); LAS float* RED = (LAS float*)(lds + G2_RED); LAS float* DSG = (LAS float*)(lds + G2_DSG); LAS float* LRS = (LAS float*)(lds + G2_LRS);
    const __amdgpu_buffer_rsrc_t rPB = mk_rsrc(PB), rMR = mk_rsrc(MRG), rSL = mk_rsrc(SLOC), rMO = mk_rsrc(MRGO), rLR = mk_rsrc(LRp);
    for (int item = vwg; item < 256; item += G) {
        const int seg = item & 7, bh = item >> 3, h = bh & 3, b = bh >> 2;
        const size_t tb = (size_t)b * SEQ + (size_t)seg * 512;
        f32x4 st[8][2];
#pragma unroll
        for (int dt = 0; dt < 8; ++dt) { st[dt][0] = (f32x4){0.f, 0.f, 0.f, 0.f}; st[dt][1] = (f32x4){0.f, 0.f, 0.f, 0.f}; }
        __syncthreads();
        if (PASS == 2 && seg > 0) {
            if (tid < 128) for (int sp = 0; sp < seg; ++sp) DSG[sp * 128 + tid] = DSEG[(size_t)(bh * 8 + sp) * 128 + tid];
            const unsigned slo = (unsigned)lane * 4u;
            float cur[64];
            { const int slu = ((bh * 8 + 0) * 8 + w) * 64 * 256;
#pragma unroll
              for (int q = 0; q < 64; ++q) cur[q] = __uint_as_float(__builtin_amdgcn_raw_buffer_load_b32(rSL, slo, slu + q * 256, 0)); }
            __syncthreads();
            for (int sp = 0; sp < seg; ++sp) {
                const int slun = ((bh * 8 + (sp + 1 < seg ? sp + 1 : sp)) * 8 + w) * 64 * 256;
#pragma unroll
                for (int dt = 0; dt < 8; ++dt) { const f32x4 dc = *(const LAS f32x4*)(DSG + sp * 128 + 16 * dt + 4 * lq);
#pragma unroll
                    for (int vt = 0; vt < 2; ++vt)
#pragma unroll
                        for (int r = 0; r < 4; ++r) { const int q = (dt * 2 + vt) * 4 + r; st[dt][vt][r] = st[dt][vt][r] * dc[r] + cur[q];
                            cur[q] = __uint_as_float(__builtin_amdgcn_raw_buffer_load_b32(rSL, slo, slun + q * 256, 0)); } }
            }
            __syncthreads();
        }
        const int dp = tid & 63, part = w, tp = tid & 31, cgp = tid >> 5;
        const int qub = (int)(((tb + 8 * part) * NB + h * 128) * 2);
        const unsigned qvo = (unsigned)dp * 4u;
        const int vub = (int)((tb * NB + 1024 + h * 256) * 2);
        const unsigned vvo = ((unsigned)(2 * tp) * NB + 16u * cgp) * 2u;
        const unsigned evo = ((unsigned)lr * NB + 4u * lq) * 2u, mvo = ((unsigned)lr * D + 4u * lq) * 2u;
        float segdec0 = 1.f, segdec1 = 1.f;
        float wg0[16], wg1[16], bg0 = 0.f, bg1 = 0.f; u32x4 lrn = {0u, 0u, 0u, 0u};
        if (PASS == 1) {
#pragma unroll
            for (int r = 0; r < 16; ++r) { const f32x2_t t = *(const f32x2_t*)(wgp + r * 512 + h * 128 + 2 * dp); wg0[r] = t.x; wg1[r] = t.y; }
            { const f32x2_t t = *(const f32x2_t*)(bgp + h * 128 + 2 * dp); bg0 = t.x; bg1 = t.y; }
            if (tid < 256) lrn = __builtin_amdgcn_raw_buffer_load_b128(rLR, (unsigned)tid * 16u, (int)(tb * 64), 0);
        }
        unsigned rq[8], rk[8], rg[8]; u32x4 rv[4];
#pragma unroll
        for (int e = 0; e < 8; ++e) { const int p = qub + e * NB * 2; if (PASS == 2) rq[e] = __builtin_amdgcn_raw_buffer_load_b32(rPB, qvo, p, 0); rk[e] = __builtin_amdgcn_raw_buffer_load_b32(rPB, qvo, p + 1024, 0); if (PASS == 2) rg[e] = __builtin_amdgcn_raw_buffer_load_b32(rPB, qvo, p + 6144, 0); }
#pragma unroll
        for (int e = 0; e < 2; ++e) { const int p = vub + e * NB * 2; rv[2 * e] = __builtin_amdgcn_raw_buffer_load_b128(rPB, vvo, p, 0); rv[2 * e + 1] = __builtin_amdgcn_raw_buffer_load_b128(rPB, vvo, p + 16, 0); }
        for (int c = 0; c < 8; ++c) {
            if (PASS == 1) {
                if (tid < 256) *(LAS u32x4*)(LRS + tid * 4) = lrn;
                if (c + 1 < 8 && tid < 256) lrn = __builtin_amdgcn_raw_buffer_load_b128(rLR, (unsigned)tid * 16u, (int)((tb + 64 * (c + 1)) * 64), 0);
                LDS_BAR0();
#pragma unroll
                for (int e = 0; e < 8; ++e) {
                    const LAS f32x4* lp = (const LAS f32x4*)(LRS + (8 * part + e) * 16);
                    float s0 = bg0, s1 = bg1;
#pragma unroll
                    for (int q = 0; q < 4; ++q) { const f32x4 lv = lp[q];
#pragma unroll
                        for (int j = 0; j < 4; ++j) { s0 += lv[j] * wg0[4 * q + j]; s1 += lv[j] * wg1[4 * q + j]; } }
                    const float a0 = (fminf(s0, 0.f) - __logf(1.f + __expf(-fabsf(s0)))) * 0.0625f, a1 = (fminf(s1, 0.f) - __logf(1.f + __expf(-fabsf(s1)))) * 0.0625f;
                    rg[e] = pg8::cvt_pk_bf16(a0, a1);
                    __builtin_amdgcn_raw_buffer_store_b32(rg[e], rPB, qvo, qub + (64 * c + e) * NB * 2 + 6144, 0);
                }
            }
            float G0[8], G1[8]; float run0 = 0.f, run1 = 0.f;
#pragma unroll
            for (int e = 0; e < 8; ++e) { run0 += bflo(rg[e]); run1 += bfhi(rg[e]); G0[e] = run0; G1[e] = run1; }
            *(LAS f32x2_t*)(TOT + part * 128 + 2 * dp) = (f32x2_t){run0, run1};
            __syncthreads();
            float off0 = 0.f, off1 = 0.f, gl0 = 0.f, gl1 = 0.f;
#pragma unroll
            for (int p = 0; p < 8; ++p) { const f32x2_t t = *(const LAS f32x2_t*)(TOT + p * 128 + 2 * dp); gl0 += t.x; gl1 += t.y; if (p < part) { off0 += t.x; off1 += t.y; } }
            const float dec0 = __expf(gl0), dec1 = __expf(gl1);
            if (part == 0) { *(LAS f32x2_t*)(DEC + 2 * dp) = (f32x2_t){dec0, dec1}; segdec0 *= dec0; segdec1 *= dec1; }
            { float kgA[8], kgB[8];
#pragma unroll
              for (int e = 0; e < 8; ++e) {
                  const float eg0 = __expf(G0[e] + off0), eg1 = __expf(G1[e] + off1), ie0 = __builtin_amdgcn_rcpf(eg0), ie1 = __builtin_amdgcn_rcpf(eg1);
                  const float kr0 = bflo(rk[e]) * ie0, kr1 = bfhi(rk[e]) * ie1; kgA[e] = kr0 * dec0; kgB[e] = kr1 * dec1;
                  if (PASS == 2) { *(LAS unsigned*)(QG + (8 * part + e) * 272 + dp * 4) = pg8::cvt_pk_bf16(bflo(rq[e]) * eg0, bfhi(rq[e]) * eg1);
                                   *(LAS unsigned*)(KR + (8 * part + e) * 272 + dp * 4) = pg8::cvt_pk_bf16(kr0, kr1); } }
              u32x4 wa, wb; wa.x = pg8::cvt_pk_bf16(kgA[0], kgA[1]); wa.y = pg8::cvt_pk_bf16(kgA[2], kgA[3]); wa.z = pg8::cvt_pk_bf16(kgA[4], kgA[5]); wa.w = pg8::cvt_pk_bf16(kgA[6], kgA[7]);
              wb.x = pg8::cvt_pk_bf16(kgB[0], kgB[1]); wb.y = pg8::cvt_pk_bf16(kgB[2], kgB[3]); wb.z = pg8::cvt_pk_bf16(kgB[4], kgB[5]); wb.w = pg8::cvt_pk_bf16(kgB[6], kgB[7]);
              *(LAS u32x4*)(KGT + (2 * dp) * 144 + part * 16) = wa; *(LAS u32x4*)(KGT + (2 * dp + 1) * 144 + part * 16) = wb; }
            { const u32x4 va0 = rv[0], va1 = rv[1], vb0 = rv[2], vb1 = rv[3];
              const unsigned av[8] = {va0.x, va0.y, va0.z, va0.w, va1.x, va1.y, va1.z, va1.w}, bv[8] = {vb0.x, vb0.y, vb0.z, vb0.w, vb1.x, vb1.y, vb1.z, vb1.w};
              LAS unsigned char* vp = VT + (16 * cgp) * 144 + tp * 4;
#pragma unroll
              for (int m = 0; m < 8; ++m) { *(LAS unsigned*)(vp + (2 * m) * 144) = (av[m] & 0xffffu) | (bv[m] << 16); *(LAS unsigned*)(vp + (2 * m + 1) * 144) = (av[m] >> 16) | (bv[m] & 0xffff0000u); } }
            __syncthreads();
            if (c + 1 < 8)
            {
#pragma unroll
                for (int e = 0; e < 8; ++e) { const int p = qub + (64 * (c + 1) + e) * NB * 2; if (PASS == 2) rq[e] = __builtin_amdgcn_raw_buffer_load_b32(rPB, qvo, p, 0); rk[e] = __builtin_amdgcn_raw_buffer_load_b32(rPB, qvo, p + 1024, 0); if (PASS == 2) rg[e] = __builtin_amdgcn_raw_buffer_load_b32(rPB, qvo, p + 6144, 0); }
#pragma unroll
                for (int e = 0; e < 2; ++e) { const int p = vub + (64 * (c + 1) + e) * NB * 2; rv[2 * e] = __builtin_amdgcn_raw_buffer_load_b128(rPB, vvo, p, 0); rv[2 * e + 1] = __builtin_amdgcn_raw_buffer_load_b128(rPB, vvo, p + 16, 0); }
            }
            f32x4 oacc[4][2];
            if (PASS == 2) {
#pragma unroll
                for (int u2 = 0; u2 < 2; ++u2) {
                    const int id = 2 * w + u2, it = id >> 2, jt = id & 3;
                    f32x4 a = {0.f, 0.f, 0.f, 0.f};
                    if (jt <= it) {
#pragma unroll
                        for (int ks = 0; ks < 4; ++ks) {
                            const bf16x8 kf = *(const LAS bf16x8*)(KR + (16 * jt + lr) * 272 + (32 * ks + 8 * lq) * 2);
                            const bf16x8 qf = *(const LAS bf16x8*)(QG + (16 * it + lr) * 272 + (32 * ks + 8 * lq) * 2);
                            a = mfma16(kf, qf, a);
                        }
                        if (jt == it) {
#pragma unroll
                            for (int r = 0; r < 4; ++r) if (4 * lq + r > lr) a[r] = 0.f; }
                    }
                    u32x2 pk; pk.x = pg8::cvt_pk_bf16(a[0], a[1]); pk.y = pg8::cvt_pk_bf16(a[2], a[3]);
                    *(LAS u32x2*)(AT + (16 * it + lr) * 144 + (16 * jt + 4 * lq) * 2) = pk;
                }
#pragma unroll
                for (int it = 0; it < 4; ++it) { oacc[it][0] = (f32x4){0.f, 0.f, 0.f, 0.f}; oacc[it][1] = (f32x4){0.f, 0.f, 0.f, 0.f}; }
#pragma unroll
                for (int ks = 0; ks < 4; ++ks) {
                    bf16x8 sf[2];
#pragma unroll
                    for (int vt = 0; vt < 2; ++vt) { u32x4 t; t.x = pg8::cvt_pk_bf16(st[2 * ks][vt][0], st[2 * ks][vt][1]); t.y = pg8::cvt_pk_bf16(st[2 * ks][vt][2], st[2 * ks][vt][3]);
                        t.z = pg8::cvt_pk_bf16(st[2 * ks + 1][vt][0], st[2 * ks + 1][vt][1]); t.w = pg8::cvt_pk_bf16(st[2 * ks + 1][vt][2], st[2 * ks + 1][vt][3]); sf[vt] = __builtin_bit_cast(bf16x8, t); }
#pragma unroll
                    for (int it = 0; it < 4; ++it) {
                        const LAS unsigned char* qp = QG + (16 * it + lr) * 272 + (32 * ks + 4 * lq) * 2;
                        const bf16x4 qa = *(const LAS bf16x4*)qp, qb = *(const LAS bf16x4*)(qp + 32);
                        const bf16x8 qf = __builtin_shufflevector(qa, qb, 0, 1, 2, 3, 4, 5, 6, 7);
                        oacc[it][0] = mfma16(sf[0], qf, oacc[it][0]); oacc[it][1] = mfma16(sf[1], qf, oacc[it][1]);
                    }
                }
                __syncthreads();
            }
            u32x2 er[4][2], ey[4][2];
            __builtin_amdgcn_sched_barrier(0);
            if (PASS == 2) {
#pragma unroll
                for (int it = 0; it < 4; ++it)
#pragma unroll
                    for (int vt = 0; vt < 2; ++vt) { const size_t tku = tb + 64 * c + 16 * it; const int colu = h * 256 + 32 * w + 16 * vt;
                        const int pu = (int)((tku * NB + 2048 + colu) * 2), mu = (int)((tku * D + colu) * 2);
                        er[it][vt] = __builtin_amdgcn_raw_buffer_load_b64(rPB, evo, pu, 0); ey[it][vt] = __builtin_amdgcn_raw_buffer_load_b64(rMR, mvo, mu, 0); }
            }
            bf16x8 vf[2][2];
#pragma unroll
            for (int vt = 0; vt < 2; ++vt)
#pragma unroll
                for (int ks = 0; ks < 2; ++ks) vf[vt][ks] = *(const LAS bf16x8*)(VT + (32 * w + 16 * vt + lr) * 144 + (32 * ks + 8 * lq) * 2);
            if (PASS == 2) {
#pragma unroll
                for (int it = 0; it < 4; ++it)
#pragma unroll
                    for (int ks = 0; ks < 2; ++ks) { if (ks == 1 && it < 2) continue;
                        const bf16x8 af = *(const LAS bf16x8*)(AT + (16 * it + lr) * 144 + (32 * ks + 8 * lq) * 2);
                        oacc[it][0] = mfma16(vf[0][ks], af, oacc[it][0]); oacc[it][1] = mfma16(vf[1][ks], af, oacc[it][1]); }
            }
            u32x2 opk[4][2];
            if (PASS == 2) {
#pragma unroll
                for (int it = 0; it < 4; ++it) { float s = 0.f;
#pragma unroll
                    for (int vt = 0; vt < 2; ++vt)
#pragma unroll
                        for (int r = 0; r < 4; ++r) s += oacc[it][vt][r] * oacc[it][vt][r];
                    s += __shfl_xor(s, 16); s += __shfl_xor(s, 32);
                    if (lq == 0) RED[w * 64 + 16 * it + lr] = s; }
#pragma unroll
                for (int it = 0; it < 4; ++it)
#pragma unroll
                    for (int vt = 0; vt < 2; ++vt) { opk[it][vt].x = pg8::cvt_pk_bf16(oacc[it][vt][0], oacc[it][vt][1]); opk[it][vt].y = pg8::cvt_pk_bf16(oacc[it][vt][2], oacc[it][vt][3]); }
            }
            __builtin_amdgcn_sched_barrier(0);
#pragma unroll
            for (int dt = 0; dt < 8; ++dt) {
                const f32x4 dc = *(const LAS f32x4*)(DEC + 16 * dt + 4 * lq);
                st[dt][0] = st[dt][0] * dc; st[dt][1] = st[dt][1] * dc;
#pragma unroll
                for (int ks = 0; ks < 2; ++ks) { const bf16x8 kf = *(const LAS bf16x8*)(KGT + (16 * dt + lr) * 144 + (32 * ks + 8 * lq) * 2);
                    st[dt][0] = mfma16(kf, vf[0][ks], st[dt][0]); st[dt][1] = mfma16(kf, vf[1][ks], st[dt][1]); }
            }
            __builtin_amdgcn_sched_barrier(0);
            if (PASS == 2) {
                __syncthreads();
#pragma unroll
                for (int half = 0; half < 2; ++half) {
#pragma unroll
                    for (int it2 = 0; it2 < 2; ++it2) { const int it = 2 * half + it2; float ss = 0.f;
#pragma unroll
                        for (int ww = 0; ww < 8; ++ww) ss += RED[ww * 64 + 16 * it + lr];
                        const float rstd = 1.0f / sqrtf(ss * (1.f / 256.f) + EPS);
#pragma unroll
                        for (int vt = 0; vt < 2; ++vt) { const size_t tku = tb + 64 * c + 16 * it; const int colu = h * 256 + 32 * w + 16 * vt;
                            const f32x4 gnv = *(const f32x4*)(gn + 32 * w + 16 * vt + 4 * lq);
                            const f32x4 ou = {bflo(opk[it][vt].x), bfhi(opk[it][vt].x), bflo(opk[it][vt].y), bfhi(opk[it][vt].y)};
                            const f32x4 o = ou * rstd * gnv;
                            const float y0 = bflo(ey[it][vt].x) + o[0] * bflo(er[it][vt].x), y1 = bfhi(ey[it][vt].x) + o[1] * bfhi(er[it][vt].x);
                            const float y2 = bflo(ey[it][vt].y) + o[2] * bflo(er[it][vt].y), y3 = bfhi(ey[it][vt].y) + o[3] * bfhi(er[it][vt].y);
                            u32x2 ow; ow.x = pg8::cvt_pk_bf16(y0, y1); ow.y = pg8::cvt_pk_bf16(y2, y3);
                            __builtin_amdgcn_raw_buffer_store_b64(ow, rMO, mvo, (int)((tku * D + colu) * 2), 0); } }
                }
            }
        }
        if (PASS == 1) {
            const int slu = ((bh * 8 + seg) * 8 + w) * 64 * 256; const unsigned slo = (unsigned)lane * 4u;
#pragma unroll
            for (int dt = 0; dt < 8; ++dt)
#pragma unroll
                for (int vt = 0; vt < 2; ++vt)
#pragma unroll
                    for (int r = 0; r < 4; ++r) __builtin_amdgcn_raw_buffer_store_b32(__float_as_uint(st[dt][vt][r]), rSL, slo, slu + ((dt * 2 + vt) * 4 + r) * 256, 0);
            if (part == 0) { DSEG[(size_t)(bh * 8 + seg) * 128 + 2 * dp] = segdec0; DSEG[(size_t)(bh * 8 + seg) * 128 + 2 * dp + 1] = segdec1; }
        }
    }
}

typedef __attribute__((address_space(1))) unsigned gu32;
#define XB_TMO      128
#define XB_XCNT(j)  (256  + 64 * (j))
#define XB_XSUB(j)  (1280 + 64 * (j))
#define XB_XGEN(j)  (2304 + 64 * (j))
#define XB_TOP      3328
#define XB_TOPGEN   3392
#define XCD_BAR_WORDS 3456
#define XB_SPIN_CAP (1u << 22)

__device__ __forceinline__ unsigned xb_ld(unsigned* p)              { return __hip_atomic_load(p, __ATOMIC_RELAXED, __HIP_MEMORY_SCOPE_AGENT); }
__device__ __forceinline__ unsigned xb_add(unsigned* p, unsigned v) { return __hip_atomic_fetch_add(p, v, __ATOMIC_RELAXED, __HIP_MEMORY_SCOPE_AGENT); }
__device__ __forceinline__ unsigned xb_xcc_id() { return (unsigned)__builtin_amdgcn_s_getreg((3 << 11) | 20) & 0xFu; }
#define XB_SPIN(cond, bar) do { unsigned _sp = 0; while (cond) { __builtin_amdgcn_s_sleep(1); \
    if ((++_sp & 255u) == 0u) { if (xb_ld(&(bar)[XB_TMO])) break; if (_sp > XB_SPIN_CAP) { atomicAdd(&(bar)[XB_TMO], 1u); break; } } } } while (0)

struct XcdBarrier {
    unsigned* bar; unsigned x;
    volatile LAS unsigned* st;
};

__device__ __forceinline__ XcdBarrier xcd_barrier_post(unsigned* bar, volatile LAS unsigned* st) {
    XcdBarrier b; b.bar = bar; b.x = xb_xcc_id(); b.st = st;
    if (threadIdx.x == 0) (void)xb_add(&bar[XB_XCNT(b.x)], 1u);
    return b;
}
__device__ __forceinline__ void xcd_barrier_complete(unsigned* bar, unsigned x, unsigned& nloc, unsigned& nx) {
    const unsigned G = gridDim.x * gridDim.y * gridDim.z;
    unsigned sum, cnt, mine, sp = 0u;
    for (;;) {
        sum = 0u; cnt = 0u; mine = 0u;
#pragma unroll
        for (unsigned j = 0; j < 16; ++j) { const unsigned c = xb_ld(&bar[XB_XCNT(j)]); sum += c; cnt += (c > 0u) ? 1u : 0u; mine = (j == x) ? c : mine; }
        if (sum == G) break;
        __builtin_amdgcn_s_sleep(1);
        if ((++sp & 255u) == 0u) { if (xb_ld(&bar[XB_TMO])) break; if (sp > XB_SPIN_CAP) { atomicAdd(&bar[XB_TMO], 1u); break; } }
    }
    nloc = mine > 0u ? mine : 1u; nx = cnt > 0u ? cnt : 1u;
}

__device__ __forceinline__ void xcd_barrier(const XcdBarrier& b) {
    asm volatile("s_waitcnt vmcnt(0)" ::: "memory");
    __syncthreads();
    if (threadIdx.x == 0) {
        unsigned* bar = b.bar;
        __builtin_amdgcn_s_waitcnt(0);
        unsigned nloc = b.st[0], nx = b.st[1];
        if (nloc == 0u) { xcd_barrier_complete(bar, b.x, nloc, nx); b.st[0] = nloc; b.st[1] = nx; }
        const unsigned old = xb_add(&bar[XB_XSUB(b.x)], 1u);
        const unsigned gen = old / nloc;
        if (old + 1u == (gen + 1u) * nloc) {
            __builtin_amdgcn_fence(__ATOMIC_RELEASE, "agent");
            asm volatile("s_waitcnt vmcnt(0)" ::: "memory");
            const unsigned og = xb_add(&bar[XB_TOP], 1u);
            const unsigned tg = og / nx;
            if (og + 1u == (tg + 1u) * nx) xb_add(&bar[XB_TOPGEN], 1u);
            else XB_SPIN(xb_ld(&bar[XB_TOPGEN]) == tg, bar);
            __builtin_amdgcn_fence(__ATOMIC_ACQUIRE, "agent");
            xb_add(&bar[XB_XGEN(b.x)], 1u);
            asm volatile("s_waitcnt vmcnt(0)" ::: "memory");
        } else {
            XB_SPIN(xb_ld(&bar[XB_XGEN(b.x)]) == gen, bar);
            __builtin_amdgcn_fence(__ATOMIC_ACQUIRE, "agent");
            asm volatile("s_waitcnt vmcnt(0)" ::: "memory");
        }
    }
    __syncthreads();
}

struct Args { const float* in[18]; float* out; unsigned char* ws; int ph_lo, ph_hi; };
constexpr int PH_PER_LAYER = 14;
constexpr int NPH = 2 * PH_PER_LAYER + 1;

__global__ void __launch_bounds__(512, 2) mega_fwd(Args a) {
    extern __shared__ __attribute__((aligned(16))) unsigned char lds_raw[];
    LAS unsigned char* lds = (LAS unsigned char*)lds_raw;
    cg::grid_group grid = cg::this_grid();
    volatile LAS unsigned* MISC = (volatile LAS unsigned*)(lds + LDS_BYTES - 512);
    if (threadIdx.x < 32) MISC[threadIdx.x] = 0u;
    __syncthreads();
    XcdBarrier bar = xcd_barrier_post((unsigned*)(a.ws + WS_CTL) + 4096, MISC + 8);
    grid.sync();
    const int G = gridDim.x, bx = blockIdx.x;
    const int vwg = (G % 8 == 0) ? (bx % 8) * (G / 8) + bx / 8 : bx;
    unsigned char* ws = a.ws;
    float* MOD = (float*)(ws + WS_MOD);
    bf16_t* H = (bf16_t*)(ws + WS_H); bf16_t* MRG = (bf16_t*)(ws + WS_MRG); bf16_t* PROJ = (bf16_t*)(ws + WS_PROJ);
    float* X = a.out;
    for (int ph0 = a.ph_lo; ph0 < a.ph_hi; ++ph0) {
        const int ph = ph0;
        if (ph == NPH - 1) { final_norm_phase(X, H, a.in[17], vwg, G); }
        else {
            const int l = ph / PH_PER_LAYER, p = ph % PH_PER_LAYER;
            const float* modl = MOD + (size_t)l * 8 * NMOD; unsigned char* wsw = ws + WS_W + (size_t)l * WS_WSTRIDE;
            if (p == 0 && l == 1) {   }
            else if (p == 0) {
                if (l == 0) mod_phase(lds, a.in[1], a.in[2], a.in[3], MOD, vwg, G);
                __syncthreads();
                LayerW L; L.f1in = a.in[5] + (size_t)l * D * NFF2; L.f1out = a.in[6] + (size_t)l * FF * D; L.mixin = a.in[8] + (size_t)l * D * INC; L.wgate = a.in[10] + (size_t)l * 16 * 512;
                L.mixout = a.in[13] + (size_t)l * D * D; L.f2in = a.in[15] + (size_t)l * D * NFF2; L.f2out = a.in[16] + (size_t)l * FF * D;
                wconv_phase(lds, L, wsw, vwg, G);
            } else if (p == 1 || p == 4 || p == 11) {
                const int q = (p == 1) ? 0 : (p == 4 ? 1 : 2);
                const float* gain = a.in[q == 0 ? 4 : (q == 1 ? 7 : 14)] + (size_t)l * D;
                const bool from_input = (l == 0 && p <= 4);
                norm_phase(from_input ? a.in[0] : X, X, H, (l == 0 && p == 1) ? 0 : 1, gain, modl + (3 * q) * D, modl + (3 * q + 1) * D, vwg, G);
            } else if (p == 2 || p == 12) {
                pg8::Gemm g{H, (const bf16_t*)(wsw + (p == 2 ? W_1IN : W_2IN)), T, NFF2, D}; pg8::StaticOrder S; S.init(T, NFF2, G, bx);
                EpiSwiGLU E{PROJ};
                pg8::gemm_phase<EpiSwiGLU, pg8::StaticOrder, true, true>(lds, g, S, E);
            } else if (p == 3 || p == 10 || p == 13) {
                const bf16_t* Aop = (p == 10) ? MRG : PROJ; const int K = (p == 10) ? D : FF;
                const bf16_t* Bop = (const bf16_t*)(wsw + (p == 3 ? W_1OUT : (p == 10 ? W_O : W_2OUT)));
                pg8::Gemm g{Aop, Bop, T, D, K}; pg8::StaticOrder S; S.init(T, D, G, bx);
                EpiResid E{H, modl + (p == 3 ? 2 : (p == 10 ? 5 : 8)) * D, p == 10 ? 1.0f : 0.5f};
                pg8::gemm_phase<EpiResid, pg8::StaticOrder, true, true>(lds, g, S, E);
            } else if (p == 5 || p == 7) {
                const int N = (p == 5) ? NAG : NBG;
                pg8::Gemm g{H, (const bf16_t*)(wsw + (p == 5 ? W_A : W_B)), T, N, D}; pg8::StaticOrder S; S.init(T, N, G, bx);
                EpiProj E{PROJ, p == 5 ? NA : NB, p == 5 ? 0 : 1, (float*)(ws + WS_LR)};
                pg8::gemm_phase<EpiProj, pg8::StaticOrder, true, true>(lds, g, S, E);
            } else if (p == 6) {
                LayerW Ln; { const int ln = 1; Ln.f1in = a.in[5] + (size_t)ln * D * NFF2; Ln.f1out = a.in[6] + (size_t)ln * FF * D; Ln.mixin = a.in[8] + (size_t)ln * D * INC; Ln.wgate = a.in[10] + (size_t)ln * 16 * 512;
                    Ln.mixout = a.in[13] + (size_t)ln * D * D; Ln.f2in = a.in[15] + (size_t)ln * D * NFF2; Ln.f2out = a.in[16] + (size_t)ln * FF * D; }
                LayerW Lc; Lc.f1in = a.in[5]; Lc.f1out = a.in[6]; Lc.mixin = a.in[8]; Lc.wgate = a.in[10]; Lc.mixout = a.in[13]; Lc.f2in = a.in[15]; Lc.f2out = a.in[16];
                att_phase(lds, PROJ, MRG, a.in[9] + l * 16, vwg, G, l == 0 ? 1 : 0, Lc, ws + WS_W, Ln, ws + WS_W + WS_WSTRIDE);
            } else if (p == 8) {
                gla2_phase<1>(lds, PROJ, MRG, (float*)H, (float*)H + (size_t)8 * 1024 * 1024, a.in[12] + (size_t)l * 256, vwg, G, MRG, (const float*)(ws + WS_LR), a.in[10] + (size_t)l * 16 * 512, a.in[11] + (size_t)l * 512);
            } else if (p == 9) {
                gla2_phase<2>(lds, PROJ, MRG, (float*)H, (float*)H + (size_t)8 * 1024 * 1024, a.in[12] + (size_t)l * 256, vwg, G, MRG, (const float*)(ws + WS_LR), a.in[10] + (size_t)l * 16 * 512, a.in[11] + (size_t)l * 512);
            }
        }
        if (ph == PH_PER_LAYER) continue;
        if (ph0 + 1 < a.ph_hi) xcd_barrier(bar);
    }
}

extern "C" void kernel_launch(void* const* d_in, const int* in_sizes, int n_in, void* d_out, int out_size, void* d_ws, size_t ws_size, hipStream_t stream) {
    static int grid = 0;
    if (grid == 0) {
        int dev = 0, cus = 0, per_cu = 0;
        hipGetDevice(&dev); hipDeviceGetAttribute(&cus, hipDeviceAttributeMultiprocessorCount, dev);
        if (hipFuncSetAttribute((const void*)mega_fwd, hipFuncAttributeMaxDynamicSharedMemorySize, LDS_BYTES) != hipSuccess) fprintf(stderr, "hipFuncSetAttribute failed\n");
        if (hipOccupancyMaxActiveBlocksPerMultiprocessor(&per_cu, (const void*)mega_fwd, 512, LDS_BYTES) != hipSuccess || per_cu < 1) per_cu = 1;
        (void)hipGetLastError();
        grid = cus * 1;
        if (ws_size < 512 * MiB) fprintf(stderr, "kernel_launch: workspace %zu smaller than expected\n", ws_size);
    }
    (void)hipMemsetAsync((char*)d_ws + WS_CTL, 0, CTL_BYTES, stream);
    Args a{};
    for (int i = 0; i < 18; ++i) a.in[i] = (const float*)d_in[i];
    a.out = (float*)d_out; a.ws = (unsigned char*)d_ws;
    a.ph_lo = 0; a.ph_hi = NPH;
    void* args[] = {&a};
    hipError_t e = hipLaunchCooperativeKernel((const void*)mega_fwd, dim3(grid), dim3(512), args, LDS_BYTES, stream);
    if (e != hipSuccess) fprintf(stderr, "cooperative launch failed: %s (grid %d)\n", hipGetErrorString(e), grid);
}
```

```cpp
#include <hip/hip_runtime.h>
#include <hip/hip_cooperative_groups.h>
#include <cstdio>
#include <cstdint>
namespace cg = cooperative_groups;
namespace pg8 {
#define PG8_LAS __attribute__((address_space(3)))
typedef unsigned short bf16_t;
typedef short bf16x8 __attribute__((ext_vector_type(8)));
typedef float f32x4 __attribute__((ext_vector_type(4)));
typedef unsigned u32x4 __attribute__((ext_vector_type(4)));
constexpr int BM = 256, BK = 64, HALF = 128, HTB = HALF * BK * 2  , STAGE_BYTES = 8 * HTB, NXCD = 8, WGM = 8;

__host__ __device__ __forceinline__ int lds_byte(int r, int c) { const int st = (r >> 4) * 2 + (c >> 5), rr = r & 15, cc = c & 31, ob = rr * 64 + cc * 2; return st * 1024 + (ob ^ (((ob >> 9) & 1) << 5)); }
__host__ __device__ __forceinline__ void stage_rc(int b, int& R, int& C) { const int st = b / 1024, sb = b % 1024, swz = sb ^ (((sb >> 9) & 1) << 5); R = (st >> 1) * 16 + swz / 64; C = (st & 1) * 32 + (swz % 64) / 2; }
__host__ __device__ __forceinline__ int perm32(int rho) { const int n = rho >> 4, i = rho & 15; return 8 * (i >> 2) + 4 * n + (i & 3); }

struct Unit { int pm, pn; };
struct Gemm { const bf16_t* A; const bf16_t* Bt; int M, N, K; };

struct StaticOrder {
    int nM, nN, nwg, G, c;
    __host__ __device__ void init(int M, int N, int G_, int c_) { nM = M / BM; nN = N / BM; nwg = nM * nN; G = G_; c = c_; }
    __host__ __device__ bool next(int i, Unit& u) const {
        const long L = (long)i * G + c; if (L >= nwg) return false;
        int wgid = (int)L; { const int q = nwg / NXCD, r = nwg % NXCD, xcd = wgid % NXCD, off = wgid / NXCD; wgid = (xcd < r ? xcd * (q + 1) : r * (q + 1) + (xcd - r) * q) + off; }
        const int nig = WGM * nN, gid = wgid / nig, fm = gid * WGM, gsz = (nM - fm) < WGM ? (nM - fm) : WGM;
        u.pm = fm + ((wgid % nig) % gsz); u.pn = (wgid % nig) / gsz; return true;
    }
    __device__ __forceinline__ void a_ready(const Unit&) const {}
    __device__ __forceinline__ void done(const Unit&) const {}
};
__device__ __forceinline__ unsigned cvt_pk_bf16(float lo, float hi) { typedef float f2_ __attribute__((ext_vector_type(2))); typedef __bf16 b2_ __attribute__((ext_vector_type(2)));
    f2_ v = {lo, hi}; b2_ r = __builtin_convertvector(v, b2_); return __builtin_bit_cast(unsigned, r); }
template <class Epi, class Sched, bool ALIGN_EPI = false, bool SP2 = false>
__device__ __forceinline__ void gemm_phase(PG8_LAS unsigned char* lds, const Gemm g, const Sched& S, const Epi& E) {
    int tid_o = threadIdx.x; asm volatile("" : "+v"(tid_o));
    const int tid = tid_o, wid = __builtin_amdgcn_readfirstlane(tid >> 6), lane = tid & 63, wr = wid >> 2, wc = wid & 3, fr = lane & 15, fq = lane >> 4;
    const int K = g.K, nt = K / BK;
    unsigned voffA[2], voffB[2];
#pragma unroll
    for (int i = 0; i < 2; ++i) { int R, C; stage_rc(tid * 16 + i * 8192, R, C); const int Rb = Epi::PERM ? ((R & ~31) + perm32(R & 31)) : R;
        voffA[i] = (unsigned)(R * K + C) * 2u; voffB[i] = (unsigned)(Rb * K + C) * 2u; }
    const size_t kstep = (size_t)(BK * 2);
    const size_t hstep = (size_t)HALF * K * 2;
    const size_t tstep = 2 * hstep;
    const unsigned ldsw = (unsigned)wid * 1024u;
    const int aoff = lds_byte(wr * 64 + fr, fq * 8), boff = lds_byte(wc * 32 + fr, fq * 8);
#define PG8_SA(b, h) (((b) * 2 + (h)) * HTB)
#define PG8_SB(b, h) ((4 + (b) * 2 + (h)) * HTB)
#define PG8_STAGE(bufoff, gbase, voff) do { _Pragma("unroll") for (int _i = 0; _i < 2; ++_i) \
        __builtin_amdgcn_global_load_lds((const unsigned*)((const char*)(gbase) + (voff)[_i]), (PG8_LAS unsigned*)(lds + (bufoff) + ldsw + _i * 8192), 16, 0, 0); } while (0)
#define PG8_LDA(dst, b, h) do { _Pragma("unroll") for (int m = 0; m < 4; ++m) _Pragma("unroll") for (int k = 0; k < 2; ++k) dst[m][k] = *(const PG8_LAS bf16x8*)(lds + PG8_SA(b, h) + aoff + m * 2048 + k * 1024); } while (0)
#define PG8_LDB(dst, b, h) do { _Pragma("unroll") for (int n = 0; n < 2; ++n) _Pragma("unroll") for (int k = 0; k < 2; ++k) dst[n][k] = *(const PG8_LAS bf16x8*)(lds + PG8_SB(b, h) + boff + n * 2048 + k * 1024); } while (0)
#define PG8_MMA(ai, bj, At, Bt) do { __builtin_amdgcn_s_setprio(1); _Pragma("unroll") for (int m = 0; m < 4; ++m) _Pragma("unroll") for (int n = 0; n < 2; ++n) _Pragma("unroll") for (int k = 0; k < 2; ++k) \
        acc[ai][bj][m][n] = __builtin_amdgcn_mfma_f32_16x16x32_bf16(Bt[n][k], At[m][k], acc[ai][bj][m][n], 0, 0, 0); __builtin_amdgcn_s_setprio(0); } while (0)
#define PG8_WAIT_V(n) asm volatile("s_waitcnt vmcnt(" #n ")" ::: "memory")
#define PG8_WAIT_L(n) asm volatile("s_waitcnt lgkmcnt(" #n ")" ::: "memory")
#define PG8_BAR __builtin_amdgcn_s_barrier()
#define PG8_SCHED __builtin_amdgcn_sched_barrier(0)
    Unit cur, nxt; int ui = 0;
    if (!S.next(0, cur)) return;
    f32x4 acc[2][2][4][2];
#pragma unroll
    for (int a = 0; a < 2; ++a)
#pragma unroll
        for (int b = 0; b < 2; ++b)
#pragma unroll
            for (int m = 0; m < 4; ++m)
#pragma unroll
                for (int n = 0; n < 2; ++n) acc[a][b][m][n] = (f32x4){0.f, 0.f, 0.f, 0.f};
    bf16x8 At[4][2], B0[2][2], B1[2][2];
    const char* cA = (const char*)g.A + (size_t)cur.pm * tstep; const char* cB = (const char*)g.Bt + (size_t)cur.pn * tstep;
    S.a_ready(cur);
    if constexpr (SP2) {
        PG8_STAGE(PG8_SB(0, 0), cB, voffB); PG8_STAGE(PG8_SB(0, 1), cB + hstep, voffB); PG8_STAGE(PG8_SA(0, 0), cA, voffA); PG8_STAGE(PG8_SA(0, 1), cA + hstep, voffA);
        if (wr == 1) PG8_BAR;
        PG8_WAIT_V(2); PG8_BAR;
        PG8_STAGE(PG8_SB(1, 0), cB + kstep, voffB); PG8_STAGE(PG8_SA(1, 0), cA + kstep, voffA); PG8_STAGE(PG8_SB(1, 1), cB + hstep + kstep, voffB);
        PG8_WAIT_V(6); PG8_BAR;
    } else {
        PG8_STAGE(PG8_SB(0, 0), cB, voffB); PG8_STAGE(PG8_SA(0, 0), cA, voffA); PG8_STAGE(PG8_SB(0, 1), cB + hstep, voffB); PG8_STAGE(PG8_SA(0, 1), cA + hstep, voffA);
        if (wr == 1) PG8_BAR;
        PG8_WAIT_V(4); PG8_BAR;
        PG8_STAGE(PG8_SB(1, 0), cB + kstep, voffB); PG8_STAGE(PG8_SA(1, 0), cA + kstep, voffA); PG8_STAGE(PG8_SB(1, 1), cB + hstep + kstep, voffB);
        PG8_WAIT_V(6); PG8_BAR;
    }
    for (;;) {
        const bool has_next = S.next(ui + 1, nxt);
        const char* nA = has_next ? (const char*)g.A + (size_t)nxt.pm * tstep : cA; const char* nB = has_next ? (const char*)g.Bt + (size_t)nxt.pn * tstep : cB;
        for (int t = 0; t < nt; t += 2) {
            const bool last = (t == nt - 2);
            const char* a1 = cA + (size_t)(t + 1) * kstep;
            const char* a2 = last ? nA : cA + (size_t)(t + 2) * kstep; const char* b2 = last ? nB : cB + (size_t)(t + 2) * kstep;
            const char* a3 = a2 + kstep; const char* b3 = b2 + kstep;
            if (last && has_next) S.a_ready(nxt);
            if constexpr (SP2) {
            PG8_LDB(B0, 0, 0); PG8_LDB(B1, 0, 1); PG8_SCHED; PG8_LDA(At, 0, 0); PG8_STAGE(PG8_SA(1, 1), a1 + hstep, voffA);
            PG8_WAIT_V(8); PG8_WAIT_L(0); PG8_BAR; PG8_MMA(0, 0, At, B0); PG8_MMA(0, 1, At, B1); PG8_BAR; PG8_SCHED;
            PG8_LDA(At, 0, 1); PG8_STAGE(PG8_SB(0, 0), b2, voffB); PG8_STAGE(PG8_SB(0, 1), b2 + hstep, voffB); PG8_STAGE(PG8_SA(0, 0), a2, voffA);
            PG8_WAIT_V(8); PG8_WAIT_L(0); PG8_BAR; PG8_MMA(1, 0, At, B0); PG8_MMA(1, 1, At, B1); PG8_BAR; PG8_SCHED;
            PG8_LDB(B0, 1, 0); PG8_LDB(B1, 1, 1); PG8_SCHED; PG8_LDA(At, 1, 0); PG8_STAGE(PG8_SA(0, 1), a2 + hstep, voffA);
            PG8_WAIT_V(8); PG8_WAIT_L(0); PG8_BAR; PG8_MMA(0, 0, At, B0); PG8_MMA(0, 1, At, B1); PG8_BAR; PG8_SCHED;
            PG8_LDA(At, 1, 1); PG8_STAGE(PG8_SB(1, 0), b3, voffB); PG8_STAGE(PG8_SB(1, 1), b3 + hstep, voffB); PG8_STAGE(PG8_SA(1, 0), a3, voffA);
            PG8_WAIT_V(8); PG8_WAIT_L(0); PG8_BAR; PG8_MMA(1, 0, At, B0); PG8_MMA(1, 1, At, B1); PG8_BAR; PG8_SCHED;
            } else {
            PG8_LDB(B0, 0, 0); PG8_SCHED; PG8_LDA(At, 0, 0); PG8_STAGE(PG8_SA(1, 1), a1 + hstep, voffA);
            PG8_WAIT_L(8); PG8_BAR; PG8_WAIT_L(0); PG8_MMA(0, 0, At, B0); PG8_BAR; PG8_SCHED;
            PG8_LDB(B1, 0, 1); PG8_STAGE(PG8_SB(0, 0), b2, voffB);
            PG8_BAR; PG8_WAIT_L(0); PG8_MMA(0, 1, At, B1); PG8_BAR;
            PG8_LDA(At, 0, 1); PG8_STAGE(PG8_SA(0, 0), a2, voffA);
            PG8_BAR; PG8_WAIT_L(0); PG8_MMA(1, 0, At, B0); PG8_BAR; PG8_SCHED;
            PG8_STAGE(PG8_SB(0, 1), b2 + hstep, voffB);
            PG8_WAIT_V(6); PG8_BAR; PG8_MMA(1, 1, At, B1); PG8_BAR;
            PG8_LDB(B0, 1, 0); PG8_SCHED; PG8_LDA(At, 1, 0); PG8_STAGE(PG8_SA(0, 1), a2 + hstep, voffA);
            PG8_WAIT_L(8); PG8_BAR; PG8_WAIT_L(0); PG8_MMA(0, 0, At, B0); PG8_BAR; PG8_SCHED;
            PG8_LDB(B1, 1, 1); PG8_STAGE(PG8_SB(1, 0), b3, voffB);
            PG8_BAR; PG8_WAIT_L(0); PG8_MMA(0, 1, At, B1); PG8_BAR;
            PG8_LDA(At, 1, 1); PG8_STAGE(PG8_SA(1, 0), a3, voffA);
            PG8_BAR; PG8_WAIT_L(0); PG8_MMA(1, 0, At, B0); PG8_BAR; PG8_SCHED;
            PG8_STAGE(PG8_SB(1, 1), b3 + hstep, voffB);
            PG8_WAIT_V(6); PG8_BAR; PG8_MMA(1, 1, At, B1); PG8_BAR;
            }
        }
        if constexpr (ALIGN_EPI) { if (wr == 0) PG8_BAR; }
        if constexpr (!Epi::AFTER_DRAIN) { E(acc, cur, wr, wc, fr, fq); S.done(cur); }
        if (!has_next) break;
#pragma unroll
        for (int a = 0; a < 2; ++a)
#pragma unroll
            for (int b = 0; b < 2; ++b)
#pragma unroll
                for (int m = 0; m < 4; ++m)
#pragma unroll
                    for (int n = 0; n < 2; ++n) acc[a][b][m][n] = (f32x4){0.f, 0.f, 0.f, 0.f};
        cur = nxt; cA = nA; cB = nB; ++ui;
        if constexpr (ALIGN_EPI) { if (wr == 1) PG8_BAR; }
    }
    PG8_WAIT_V(0);
    if constexpr (!ALIGN_EPI) { if (wr == 0) PG8_BAR; }
    PG8_BAR;
    if constexpr (Epi::AFTER_DRAIN) { E.fused(acc, cur, wr, wc, fr, fq, lds, wid, lane); S.done(cur); }
#undef PG8_SA
#undef PG8_SB
#undef PG8_STAGE
#undef PG8_LDA
#undef PG8_LDB
#undef PG8_MMA
#undef PG8_WAIT_V
#undef PG8_WAIT_L
#undef PG8_BAR
#undef PG8_SCHED
}
}

#define LAS __attribute__((address_space(3)))
typedef unsigned short bf16_t;
typedef short bf16x8 __attribute__((ext_vector_type(8)));
typedef short bf16x4 __attribute__((ext_vector_type(4)));
typedef float f32x4 __attribute__((ext_vector_type(4)));
typedef unsigned u32x4 __attribute__((ext_vector_type(4)));
typedef unsigned u32x2 __attribute__((ext_vector_type(2)));
typedef float f32x2_t __attribute__((ext_vector_type(2)));
constexpr int T = 32768, D = 1024, FF = 2816, NFF2 = 5632, SEQ = 4096, NMOD = 9216, INC = 6416;
constexpr int NA = 2304, NAG = 2560, NBG = 4096, NB = 3584;
constexpr float EPS = 1e-6f;
constexpr size_t MiB = 1u << 20;
constexpr size_t WS_CTL = 0, CTL_BYTES = 65536;
constexpr size_t WS_MOD = 65536;
constexpr size_t WS_W = 1 * MiB, WS_WSTRIDE = 49 * MiB;
constexpr size_t W_1IN = 0, W_1OUT = W_1IN + (size_t)NFF2 * D * 2, W_A = W_1OUT + (size_t)D * FF * 2, W_B = W_A + (size_t)NAG * D * 2,
                 W_O = W_B + (size_t)NBG * D * 2, W_2IN = W_O + (size_t)D * D * 2, W_2OUT = W_2IN + (size_t)NFF2 * D * 2, W_END = W_2OUT + (size_t)D * FF * 2;
static_assert(W_END <= 49 * MiB, "weights");
constexpr size_t WS_H = 99 * MiB;
constexpr size_t WS_MRG = 163 * MiB;
constexpr size_t WS_PROJ = 227 * MiB;
static_assert((size_t)T * NB * 2 <= 224 * MiB && (size_t)T * FF * 2 <= 224 * MiB && (size_t)T * NA * 2 <= 224 * MiB, "PROJ region = 224 MiB");
constexpr size_t WS_LR = 451 * MiB;
constexpr int LDS_BYTES = 147456;

__device__ __forceinline__ float bf2f(unsigned v) { return __uint_as_float(v << 16); }
__device__ __forceinline__ float bflo(unsigned v) { return __uint_as_float(v << 16); }
__device__ __forceinline__ float bfhi(unsigned v) { return __uint_as_float(v & 0xffff0000u); }
__device__ __forceinline__ float wave_sum(float v) {
#pragma unroll
    for (int o = 1; o < 64; o <<= 1) v += __shfl_xor(v, o);
    return v;
}
__device__ __forceinline__ float sigm(float v) { return __builtin_amdgcn_rcpf(1.f + __expf(-v)); }
__device__ __forceinline__ f32x4 mfma16(bf16x8 a, bf16x8 b, f32x4 c) { return __builtin_amdgcn_mfma_f32_16x16x32_bf16(a, b, c, 0, 0, 0); }

__device__ __forceinline__ int otid() { int t = threadIdx.x; asm volatile("" : "+v"(t)); return t; }
using pg8::Unit;
struct EpiSwiGLU {
    static constexpr bool PERM = true, AFTER_DRAIN = false;
    bf16_t* O;
    __device__ __forceinline__ void operator()(const f32x4 (&acc)[2][2][4][2], const Unit& u, int wr, int wc, int fr, int fq) const {
        const int row0 = u.pm * 256 + wr * 64 + fr, col0 = u.pn * 128 + wc * 32 + 8 * fq;
#pragma unroll
        for (int ai = 0; ai < 2; ++ai)
#pragma unroll
            for (int m = 0; m < 4; ++m) {
                bf16_t* rowp = O + (size_t)(row0 + ai * 128 + m * 16) * FF + col0;
                float v[8];
#pragma unroll
                for (int n = 0; n < 2; ++n)
#pragma unroll
                    for (int j = 0; j < 4; ++j) { const float g = acc[ai][0][m][n][j], up = acc[ai][1][m][n][j]; v[n * 4 + j] = g * sigm(g) * up; }
                u32x4 w; w.x = pg8::cvt_pk_bf16(v[0], v[1]); w.y = pg8::cvt_pk_bf16(v[2], v[3]); w.z = pg8::cvt_pk_bf16(v[4], v[5]); w.w = pg8::cvt_pk_bf16(v[6], v[7]);
                *(u32x4*)rowp = w;
            }
    }
};
struct EpiResid {
    static constexpr bool PERM = true, AFTER_DRAIN = false;
    bf16_t* Dl; const float* gate; float coef;
    __device__ __forceinline__ void operator()(const f32x4 (&acc)[2][2][4][2], const Unit& u, int wr, int wc, int fr, int fq) const {
        const int row0 = u.pm * 256 + wr * 64 + fr, b = u.pm >> 4;
#pragma unroll
        for (int bj = 0; bj < 2; ++bj) {
            const int col0 = u.pn * 256 + bj * 128 + wc * 32 + 8 * fq;
            const f32x4 g0 = *(const f32x4*)(gate + (size_t)b * NMOD + col0) * coef, g1 = *(const f32x4*)(gate + (size_t)b * NMOD + col0 + 4) * coef;
#pragma unroll
            for (int ai = 0; ai < 2; ++ai)
#pragma unroll
                for (int m = 0; m < 4; ++m) { const f32x4 v0 = acc[ai][bj][m][0] * g0, v1 = acc[ai][bj][m][1] * g1;
                    u32x4 w; w.x = pg8::cvt_pk_bf16(v0[0], v0[1]); w.y = pg8::cvt_pk_bf16(v0[2], v0[3]); w.z = pg8::cvt_pk_bf16(v1[0], v1[1]); w.w = pg8::cvt_pk_bf16(v1[2], v1[3]);
                    *(u32x4*)(Dl + (size_t)(row0 + ai * 128 + m * 16) * D + col0) = w; }
        }
    }
};
struct EpiProj {
    static constexpr bool PERM = true, AFTER_DRAIN = false;
    bf16_t* O; int ldc; int mode; float* LR;
    __device__ __forceinline__ void operator()(const f32x4 (&acc)[2][2][4][2], const Unit& u, int wr, int wc, int fr, int fq) const {
        const int row0 = u.pm * 256 + wr * 64 + fr;
        if (mode == 0 && u.pn == 9) {
            if (wc == 0 && fq < 2) {
#pragma unroll
                for (int ai = 0; ai < 2; ++ai)
#pragma unroll
                    for (int m = 0; m < 4; ++m) { float* lp = LR + (size_t)(row0 + ai * 128 + m * 16) * 16 + 8 * fq; *(f32x4*)lp = acc[ai][0][m][0]; *(f32x4*)(lp + 4) = acc[ai][0][m][1]; }
            }
            return;
        }
        if (mode == 1 && u.pn >= 8 && u.pn < 16) {
            const int col0 = 2048 + 128 * (u.pn - 8) + wc * 32 + 8 * fq;
#pragma unroll
            for (int ai = 0; ai < 2; ++ai)
#pragma unroll
                for (int m = 0; m < 4; ++m) {
                    float v[8];
#pragma unroll
                    for (int n = 0; n < 2; ++n)
#pragma unroll
                        for (int j = 0; j < 4; ++j) { const float r_ = acc[ai][0][m][n][j], g_ = acc[ai][1][m][n][j]; v[n * 4 + j] = r_ * sigm(r_) * sigm(g_); }
                    u32x4 w; w.x = pg8::cvt_pk_bf16(v[0], v[1]); w.y = pg8::cvt_pk_bf16(v[2], v[3]); w.z = pg8::cvt_pk_bf16(v[4], v[5]); w.w = pg8::cvt_pk_bf16(v[6], v[7]);
                    *(u32x4*)(O + (size_t)(row0 + ai * 128 + m * 16) * ldc + col0) = w;
                }
            return;
        }
#pragma unroll
        for (int bj = 0; bj < 2; ++bj) {
            const int c0 = u.pn * 256 + bj * 128;
            int code, oc0 = c0; float sc = 1.f;
            if (mode == 0) { if (c0 < 1024) { code = 0; sc = 0.125f; } else if (c0 < 1280) code = 0; else code = 1; }
            else { code = 0; if (c0 < 512) sc = 0.08838834764831845f; }
            const int col0 = oc0 + wc * 32 + 8 * fq;
#pragma unroll
            for (int ai = 0; ai < 2; ++ai)
#pragma unroll
                for (int m = 0; m < 4; ++m) {
                    float v[8];
#pragma unroll
                    for (int n = 0; n < 2; ++n)
#pragma unroll
                        for (int j = 0; j < 4; ++j) { float x = acc[ai][bj][m][n][j];
                            if (code == 0) x = x * sc;
                            else x = sigm(x);
                            v[n * 4 + j] = x; }
                    u32x4 w; w.x = pg8::cvt_pk_bf16(v[0], v[1]); w.y = pg8::cvt_pk_bf16(v[2], v[3]); w.z = pg8::cvt_pk_bf16(v[4], v[5]); w.w = pg8::cvt_pk_bf16(v[6], v[7]);
                    *(u32x4*)(O + (size_t)(row0 + ai * 128 + m * 16) * ldc + col0) = w;
                }
        }
    }
};

__device__ __forceinline__ void transpose_item(const float* W, int Nsrc, int K, bf16_t* WT, int k0, int srccol0, int dstrow0, LAS float* scr, int lane) {
#pragma unroll 8
    for (int i = 0; i < 32; ++i) { const int kk = 2 * i + (lane >> 5); scr[kk * 33 + (lane & 31)] = W[(size_t)(k0 + kk) * Nsrc + srccol0 + (lane & 31)]; }
    asm volatile("s_waitcnt lgkmcnt(0)" ::: "memory");
    const int c = lane & 7;
#pragma unroll
    for (int j = 0; j < 4; ++j) { const int n = (lane >> 3) + 8 * j; const LAS float* s = scr + (8 * c) * 33 + n;
        u32x4 o; o.x = pg8::cvt_pk_bf16(s[0 * 33], s[1 * 33]); o.y = pg8::cvt_pk_bf16(s[2 * 33], s[3 * 33]); o.z = pg8::cvt_pk_bf16(s[4 * 33], s[5 * 33]); o.w = pg8::cvt_pk_bf16(s[6 * 33], s[7 * 33]);
        *(u32x4*)(WT + (size_t)(dstrow0 + n) * K + k0 + 8 * c) = o; }
    asm volatile("s_waitcnt lgkmcnt(0)" ::: "memory");
}
__device__ __forceinline__ int map_src(int mapid, int r) {
    if (mapid == 1) { const int pn = r >> 8, bj = (r >> 7) & 1, j = r & 127; return bj * FF + 128 * pn + j; }
    if (mapid == 2) return r < 1280 ? r : (r < 2304 ? r + 3088 : 3328 + (r - 2304));
    if (mapid == 3) { if (r < 2048) return r + 1280; const int rr = r - 2048, t = rr >> 8, bj = (rr >> 7) & 1, j = rr & 127; return (bj ? 5392 : 3344) + 128 * t + j; }
    return r;
}
struct ConvItem { const float* W; bf16_t* WT; int Nsrc, K, k0, srccol0, dstrow0; };
__device__ __forceinline__ void tr_load(const ConvItem& ci, int lane, float (&tv)[32]) {
#pragma unroll
    for (int i = 0; i < 32; ++i) { const int kk = 2 * i + (lane >> 5); tv[i] = ci.W[(size_t)(ci.k0 + kk) * ci.Nsrc + ci.srccol0 + (lane & 31)]; }
}
__device__ __forceinline__ void tr_finish(const ConvItem& ci, int lane, const float (&tv)[32], LAS float* scr) {
#pragma unroll
    for (int i = 0; i < 32; ++i) { const int kk = 2 * i + (lane >> 5); scr[kk * 33 + (lane & 31)] = tv[i]; }
    asm volatile("s_waitcnt lgkmcnt(0)" ::: "memory");
    const int c = lane & 7;
#pragma unroll
    for (int j = 0; j < 4; ++j) { const int n = (lane >> 3) + 8 * j; const LAS float* s = scr + (8 * c) * 33 + n;
        u32x4 o; o.x = pg8::cvt_pk_bf16(s[0 * 33], s[1 * 33]); o.y = pg8::cvt_pk_bf16(s[2 * 33], s[3 * 33]); o.z = pg8::cvt_pk_bf16(s[4 * 33], s[5 * 33]); o.w = pg8::cvt_pk_bf16(s[6 * 33], s[7 * 33]);
        *(u32x4*)(ci.WT + (size_t)(ci.dstrow0 + n) * ci.K + ci.k0 + 8 * c) = o; }
    asm volatile("s_waitcnt lgkmcnt(0)" ::: "memory");
}
__device__ __forceinline__ bool conv_try(int& it, const float* W, int Nsrc, int K, bf16_t* WT, int ndst, int mapid, LAS float* scr, int lane) {
    const int ng = ndst / 32, n = (K / 64) * ng;
    if (it >= n) { it -= n; return false; }
    const int kb = it / ng, g = it % ng;
    transpose_item(W, Nsrc, K, WT, 64 * kb, map_src(mapid, 32 * g), 32 * g, scr, lane);
    return true;
}
struct LayerW { const float *f1in, *f1out, *mixin, *wgate, *mixout, *f2in, *f2out; };
constexpr int CONV_NITEMS = 2 * (16 * 176) + 2 * (44 * 32) + 16 * 80 + 16 * 128 + 16 * 32;
__device__ __forceinline__ bool conv_pick(int& it, const float* W, int Nsrc, int K, bf16_t* WT, int ndst, int mapid, ConvItem& ci) {
    const int ng = ndst / 32, n = (K / 64) * ng;
    if (it >= n) { it -= n; return false; }
    const int kb = it / ng, g = it % ng;
    ci.W = W; ci.WT = WT; ci.Nsrc = Nsrc; ci.K = K; ci.k0 = 64 * kb; ci.srccol0 = map_src(mapid, 32 * g); ci.dstrow0 = 32 * g; return true;
}
constexpr int CONV_LATE = 16 * 176 + 44 * 32 + 16 * 32;
__device__ __forceinline__ ConvItem conv_decode_late(int it, const LayerW& L, unsigned char* wsw) {
    ConvItem ci;
    if (conv_pick(it, L.f2in, NFF2, D, (bf16_t*)(wsw + W_2IN), NFF2, 1, ci)) return ci;
    if (conv_pick(it, L.f2out, D, FF, (bf16_t*)(wsw + W_2OUT), D, 0, ci)) return ci;
    conv_pick(it, L.mixout, D, D, (bf16_t*)(wsw + W_O), D, 0, ci); return ci;
}
__device__ __forceinline__ ConvItem conv_decode(int it, const LayerW& L, unsigned char* wsw) {
    ConvItem ci;
    if (conv_pick(it, L.f1in, NFF2, D, (bf16_t*)(wsw + W_1IN), NFF2, 1, ci)) return ci;
    if (conv_pick(it, L.f2in, NFF2, D, (bf16_t*)(wsw + W_2IN), NFF2, 1, ci)) return ci;
    if (conv_pick(it, L.f1out, D, FF, (bf16_t*)(wsw + W_1OUT), D, 0, ci)) return ci;
    if (conv_pick(it, L.f2out, D, FF, (bf16_t*)(wsw + W_2OUT), D, 0, ci)) return ci;
    if (conv_pick(it, L.mixin, INC, D, (bf16_t*)(wsw + W_A), NAG, 2, ci)) return ci;
    if (conv_pick(it, L.mixin, INC, D, (bf16_t*)(wsw + W_B), 4096, 3, ci)) return ci;
    conv_pick(it, L.mixout, D, D, (bf16_t*)(wsw + W_O), D, 0, ci); return ci;
}
__device__ __forceinline__ void wconv_phase(LAS unsigned char* lds, const LayerW& L, unsigned char* wsw, int vwg, int G) {
    const int tid = otid(), lane = tid & 63, wave = __builtin_amdgcn_readfirstlane(tid >> 6);
    LAS float* scr = (LAS float*)(lds + wave * 8704);
    const int gw = vwg * 8 + wave, NGW = G * 8;
    constexpr int NITEMS = 16 * 176 + 44 * 32 + 16 * 80 + 16 * 128;
    for (int it0 = gw; it0 < NITEMS; it0 += NGW) {
        int it = it0;
        if (conv_try(it, L.f1in, NFF2, D, (bf16_t*)(wsw + W_1IN), NFF2, 1, scr, lane)) continue;
        if (conv_try(it, L.f1out, D, FF, (bf16_t*)(wsw + W_1OUT), D, 0, scr, lane)) continue;
        if (conv_try(it, L.mixin, INC, D, (bf16_t*)(wsw + W_A), NAG, 2, scr, lane)) continue;
        conv_try(it, L.mixin, INC, D, (bf16_t*)(wsw + W_B), 4096, 3, scr, lane);
    }
}
__device__ __forceinline__ void mod_phase(LAS unsigned char* lds, const float* c, const float* ada_w, const float* ada_b, float* MOD, int vwg, int G) {
    const int tid = otid(), lane = tid & 63, wave = __builtin_amdgcn_readfirstlane(tid >> 6);
    LAS float* cond = (LAS float*)lds;
    LAS float* red = (LAS float*)(lds + 32768);
    for (int i = tid; i < 8 * D; i += 512) { const float v = c[i]; cond[i] = v * sigm(v); }
    __syncthreads();
    for (int item = vwg; item < 2 * (NMOD / 64); item += G) {
        const int l = item / (NMOD / 64), n0 = (item % (NMOD / 64)) * 64;
        const float* wp = ada_w + (size_t)l * D * NMOD + (size_t)(wave * 128) * NMOD + n0 + lane;
        float acc[8];
#pragma unroll
        for (int b = 0; b < 8; ++b) acc[b] = 0.f;
        for (int k4 = 0; k4 < 32; ++k4) {
            float wv[4];
#pragma unroll
            for (int j = 0; j < 4; ++j) wv[j] = wp[(size_t)(k4 * 4 + j) * NMOD];
#pragma unroll
            for (int b = 0; b < 8; ++b) { const f32x4 cv = *(const LAS f32x4*)(cond + b * D + wave * 128 + k4 * 4); acc[b] += cv[0] * wv[0] + cv[1] * wv[1] + cv[2] * wv[2] + cv[3] * wv[3]; }
        }
#pragma unroll
        for (int b = 0; b < 8; ++b) red[(wave * 8 + b) * 64 + lane] = acc[b];
        __syncthreads();
        { const int b = tid >> 6; float s = ada_b[(size_t)l * NMOD + n0 + lane];
#pragma unroll
          for (int w = 0; w < 8; ++w) s += red[(w * 8 + b) * 64 + lane];
          MOD[((size_t)l * 8 + b) * NMOD + n0 + lane] = s; }
        __syncthreads();
    }
}

__device__ __forceinline__ void norm_phase(const float* Xin, float* Xout, bf16_t* H, int has_delta, const float* gain, const float* shift, const float* scale, int vwg, int G) {
    const int tid_ = otid(), lane = tid_ & 63, wave = __builtin_amdgcn_readfirstlane(tid_ >> 6);
    for (int rg = vwg * 8 + wave; rg < T / 16; rg += G * 8) {
        const int row0 = rg * 16, b = row0 / SEQ;
        f32x4 A[4], Bs[4];
#pragma unroll
        for (int j = 0; j < 4; ++j) { const int cidx = 4 * lane + 256 * j; const f32x4 g = *(const f32x4*)(gain + cidx), sc = *(const f32x4*)(scale + (size_t)b * NMOD + cidx);
            A[j] = g * (sc + 1.0f); Bs[j] = *(const f32x4*)(shift + (size_t)b * NMOD + cidx); }
        f32x4 nx[4], mx[4]; u32x2 nd[4], md[4];
#pragma unroll
        for (int j = 0; j < 4; ++j) { nx[j] = ((const f32x4*)(Xin + (size_t)row0 * D) + lane)[64 * j]; nd[j] = has_delta ? ((const u32x2*)(H + (size_t)row0 * D) + lane)[64 * j] : (u32x2){0u, 0u};
            mx[j] = ((const f32x4*)(Xin + (size_t)(row0 + 1) * D) + lane)[64 * j]; md[j] = has_delta ? ((const u32x2*)(H + (size_t)(row0 + 1) * D) + lane)[64 * j] : (u32x2){0u, 0u}; }
        for (int r = 0; r < 16; ++r) {
            u32x2* o8 = (u32x2*)(H + (size_t)(row0 + r) * D) + lane;
            f32x4 v[4]; float s = 0.f;
#pragma unroll
            for (int j = 0; j < 4; ++j) { v[j] = nx[j] + (f32x4){bflo(nd[j].x), bfhi(nd[j].x), bflo(nd[j].y), bfhi(nd[j].y)};
                s += (v[j][0] * v[j][0] + v[j][1] * v[j][1]) + (v[j][2] * v[j][2] + v[j][3] * v[j][3]); nx[j] = mx[j]; nd[j] = md[j]; }
            if (r + 2 < 16) { const f32x4* xr = (const f32x4*)(Xin + (size_t)(row0 + r + 2) * D) + lane; const u32x2* dr = (const u32x2*)(H + (size_t)(row0 + r + 2) * D) + lane;
#pragma unroll
                for (int j = 0; j < 4; ++j) { mx[j] = xr[64 * j]; md[j] = has_delta ? dr[64 * j] : (u32x2){0u, 0u}; } }
            if (has_delta) { f32x4* xo = (f32x4*)(Xout + (size_t)(row0 + r) * D) + lane;
#pragma unroll
                for (int j = 0; j < 4; ++j) xo[64 * j] = v[j]; }
            const float rstd = 1.0f / sqrtf(wave_sum(s) * (1.f / D) + EPS);
#pragma unroll
            for (int j = 0; j < 4; ++j) { const f32x4 y = (v[j] * rstd) * A[j] + Bs[j]; u32x2 w; w.x = pg8::cvt_pk_bf16(y[0], y[1]); w.y = pg8::cvt_pk_bf16(y[2], y[3]); o8[64 * j] = w; }
        }
    }
}
__device__ __forceinline__ void final_norm_phase(float* X, const bf16_t* H, const float* gain, int vwg, int G) {
    const int tid_ = otid(), lane = tid_ & 63, wave = __builtin_amdgcn_readfirstlane(tid_ >> 6);
    f32x4 A[4];
#pragma unroll
    for (int j = 0; j < 4; ++j) A[j] = *(const f32x4*)(gain + 4 * lane + 256 * j);
    const int rstep = G * 8; int row = vwg * 8 + wave;
    f32x4 nx[4]; u32x2 nd[4];
    if (row < T) {
#pragma unroll
        for (int j = 0; j < 4; ++j) { nx[j] = ((const f32x4*)(X + (size_t)row * D) + lane)[64 * j]; nd[j] = ((const u32x2*)(H + (size_t)row * D) + lane)[64 * j]; } }
    for (; row < T; row += rstep) {
        f32x4* xr = (f32x4*)(X + (size_t)row * D) + lane;
        f32x4 v[4]; float s = 0.f;
#pragma unroll
        for (int j = 0; j < 4; ++j) { v[j] = nx[j] + (f32x4){bflo(nd[j].x), bfhi(nd[j].x), bflo(nd[j].y), bfhi(nd[j].y)}; s += (v[j][0] * v[j][0] + v[j][1] * v[j][1]) + (v[j][2] * v[j][2] + v[j][3] * v[j][3]); }
        if (row + rstep < T) {
#pragma unroll
            for (int j = 0; j < 4; ++j) { nx[j] = ((const f32x4*)(X + (size_t)(row + rstep) * D) + lane)[64 * j]; nd[j] = ((const u32x2*)(H + (size_t)(row + rstep) * D) + lane)[64 * j]; } }
        const float rstd = 1.0f / sqrtf(wave_sum(s) * (1.f / D) + EPS);
#pragma unroll
        for (int j = 0; j < 4; ++j) xr[64 * j] = (v[j] * rstd) * A[j];
    }
}

__device__ __forceinline__ __amdgpu_buffer_rsrc_t mk_rsrc(const void* p) { return __builtin_amdgcn_make_buffer_rsrc((void*)p, 0, 0x7fffffff, 0x00020000); }
__device__ __forceinline__ void att_phase(LAS unsigned char* lds, const bf16_t* PA, bf16_t* MRG, const float* sinks, int vwg, int G, int do_conv, const LayerW& Lc, unsigned char* wswc, const LayerW& Ln, unsigned char* wswn) {
    const int tid = otid(), lane = tid & 63, w = __builtin_amdgcn_readfirstlane(tid >> 6), lr = lane & 15, lq = lane >> 4;
    LAS unsigned char* Kimg = lds;
    LAS unsigned char* VT = lds + 36864;
    const __amdgpu_buffer_rsrc_t rPA = mk_rsrc(PA), rMR = mk_rsrc(MRG);
    const unsigned qvo = ((unsigned)lr * NA + 8u * lq) * 2u;
    const unsigned gvo = ((unsigned)lr * NA + 4u * lq) * 2u;
    const unsigned ovo = ((unsigned)lr * D + 4u * lq) * 2u;
    for (int e = tid; e < 64 * 16; e += 512) *(LAS bf16_t*)(VT + (e >> 4) * 560 + (256 + (e & 15)) * 2) = 0;
    LAS float* cscr = (LAS float*)(lds + 72704 + w * 8448);
    const int cgw = vwg * 8 + w, cNGW = G * 8; int cslot = 0;
    for (int item = vwg; item < 512; item += G) {
        const int g = item & 1, nbk = (item >> 1) & 31, b = item >> 6;
        const int t0 = b * SEQ + nbk * 128;
        const int hq = 8 * g + w;
        u32x4 qn0 = __builtin_amdgcn_raw_buffer_load_b128(rPA, qvo, (t0 * NA + hq * 64) * 2, 0), qn1 = __builtin_amdgcn_raw_buffer_load_b128(rPA, qvo, (t0 * NA + hq * 64 + 32) * 2, 0);
        u32x2 gn_[4];
#pragma unroll
        for (int dt = 0; dt < 4; ++dt) gn_[dt] = __builtin_amdgcn_raw_buffer_load_b64(rPA, gvo, (t0 * NA + 1280 + hq * 64 + 16 * dt) * 2, 0);
        __syncthreads();
#pragma unroll
        for (int c = 0; c < 4; ++c) {
            const int id = tid + 512 * c, row = id >> 3, piece = id & 7;
            u32x4 kv = {0u, 0u, 0u, 0u}, vv = {0u, 0u, 0u, 0u};
            if (nbk > 0 || row >= 128) { const bf16_t* p = PA + (size_t)(t0 - 128 + row) * NA + 1024 + 64 * g + 8 * piece; kv = *(const u32x4*)p; vv = *(const u32x4*)(p + 128); }
            *(LAS u32x4*)(Kimg + row * 144 + piece * 16) = kv;
            LAS bf16_t* vt = (LAS bf16_t*)VT + (8 * piece) * 280 + row;
            vt[0 * 280] = (bf16_t)(vv.x & 0xffffu); vt[1 * 280] = (bf16_t)(vv.x >> 16); vt[2 * 280] = (bf16_t)(vv.y & 0xffffu); vt[3 * 280] = (bf16_t)(vv.y >> 16);
            vt[4 * 280] = (bf16_t)(vv.z & 0xffffu); vt[5 * 280] = (bf16_t)(vv.z >> 16); vt[6 * 280] = (bf16_t)(vv.w & 0xffffu); vt[7 * 280] = (bf16_t)(vv.w >> 16);
        }
        __syncthreads();
        const float sink = sinks[hq];
        for (int mt = 0; mt < 8; ++mt) {
            const bf16x8 qf0 = __builtin_bit_cast(bf16x8, qn0), qf1 = __builtin_bit_cast(bf16x8, qn1);
            u32x2 gc[4];
#pragma unroll
            for (int dt = 0; dt < 4; ++dt) gc[dt] = gn_[dt];
            if (mt + 1 < 8) {
                const int tn = (t0 + 16 * (mt + 1)) * NA;
                qn0 = __builtin_amdgcn_raw_buffer_load_b128(rPA, qvo, (tn + hq * 64) * 2, 0); qn1 = __builtin_amdgcn_raw_buffer_load_b128(rPA, qvo, (tn + hq * 64 + 32) * 2, 0);
#pragma unroll
                for (int dt = 0; dt < 4; ++dt) gn_[dt] = __builtin_amdgcn_raw_buffer_load_b64(rPA, gvo, (tn + 1280 + hq * 64 + 16 * dt) * 2, 0);
            }
            const int cit = cgw + cslot * cNGW; const bool cdo = do_conv && cit < CONV_LATE + CONV_NITEMS;
            ConvItem ci; float tv[32];
            if (cdo) { ci = (cit < CONV_LATE) ? conv_decode_late(cit, Lc, wswc) : conv_decode(cit - CONV_LATE, Ln, wswn); tr_load(ci, lane, tv); }
            f32x4 s[9];
#pragma unroll
            for (int a = 0; a < 9; ++a) {
                const LAS unsigned char* kp = Kimg + (16 * (mt + a) + lr) * 144 + lq * 16;
                const bf16x8 k0 = *(const LAS bf16x8*)kp, k1 = *(const LAS bf16x8*)(kp + 64);
                f32x4 z = {0.f, 0.f, 0.f, 0.f};
                z = mfma16(k0, qf0, z); z = mfma16(k1, qf1, z); s[a] = z;
            }
            const int i = 16 * mt + lr;
            float mx = sink;
#pragma unroll
            for (int a = 0; a < 9; ++a)
#pragma unroll
                for (int r = 0; r < 4; ++r) { const int j = 16 * (mt + a) + 4 * lq + r, dd = j - i; const bool valid = (dd >= 1) && (dd <= 128) && (nbk > 0 || j >= 128);
                    const float v = valid ? s[a][r] : -INFINITY; s[a][r] = v; mx = fmaxf(mx, v); }
            mx = fmaxf(mx, __shfl_xor(mx, 16)); mx = fmaxf(mx, __shfl_xor(mx, 32));
            float sum = 0.f;
#pragma unroll
            for (int a = 0; a < 9; ++a)
#pragma unroll
                for (int r = 0; r < 4; ++r) { const float p = __expf(s[a][r] - mx); s[a][r] = p; sum += p; }
            sum += __shfl_xor(sum, 16); sum += __shfl_xor(sum, 32);
            const float inv = 1.0f / (sum + __expf(sink - mx));
            bf16x8 pf[5];
#pragma unroll
            for (int kk = 0; kk < 5; ++kk) {
                u32x4 wv; wv.x = pg8::cvt_pk_bf16(s[2 * kk][0] * inv, s[2 * kk][1] * inv); wv.y = pg8::cvt_pk_bf16(s[2 * kk][2] * inv, s[2 * kk][3] * inv);
                if (kk < 4) { wv.z = pg8::cvt_pk_bf16(s[2 * kk + 1][0] * inv, s[2 * kk + 1][1] * inv); wv.w = pg8::cvt_pk_bf16(s[2 * kk + 1][2] * inv, s[2 * kk + 1][3] * inv); } else { wv.z = 0u; wv.w = 0u; }
                pf[kk] = __builtin_bit_cast(bf16x8, wv);
            }
#pragma unroll
            for (int dt = 0; dt < 4; ++dt) {
                f32x4 o = {0.f, 0.f, 0.f, 0.f};
#pragma unroll
                for (int kk = 0; kk < 5; ++kk) {
                    const LAS unsigned char* vp = VT + (16 * dt + lr) * 560 + (16 * (mt + 2 * kk) + 4 * lq) * 2;
                    const bf16x4 v0 = *(const LAS bf16x4*)vp, v1 = *(const LAS bf16x4*)(vp + 32);
                    const bf16x8 vf = __builtin_shufflevector(v0, v1, 0, 1, 2, 3, 4, 5, 6, 7);
                    o = mfma16(vf, pf[kk], o);
                }
                const u32x2 ga = gc[dt];
                u32x2 ow; ow.x = pg8::cvt_pk_bf16(o[0] * bflo(ga.x), o[1] * bfhi(ga.x)); ow.y = pg8::cvt_pk_bf16(o[2] * bflo(ga.y), o[3] * bfhi(ga.y));
                __builtin_amdgcn_raw_buffer_store_b64(ow, rMR, ovo, ((t0 + 16 * mt) * D + hq * 64 + 16 * dt) * 2, 0);
            }
            if (cdo) tr_finish(ci, lane, tv, cscr);
            ++cslot;
        }
    }
    if (do_conv) {
        for (; cgw + cslot * cNGW < CONV_LATE + CONV_NITEMS; ++cslot) { const int cit = cgw + cslot * cNGW; float tv[32];
            const ConvItem ci = (cit < CONV_LATE) ? conv_decode_late(cit, Lc, wswc) : conv_decode(cit - CONV_LATE, Ln, wswn);
            tr_load(ci, lane, tv); tr_finish(ci, lane, tv, cscr); }
    }
}

#define LDS_BAR0() do { asm volatile("s_waitcnt lgkmcnt(0)" ::: "memory"); __builtin_amdgcn_s_barrier(); asm volatile("" ::: "memory"); } while (0)
constexpr int G2_QG = 0, G2_KR = 17408, G2_KGT = 34816, G2_VT = 53248, G2_AT = 90112, G2_DEC = 99328, G2_TOT = 99840, G2_RED = 103936, G2_DSG = 105984, G2_LRS = 110080;
template <int PASS>
__device__ __forceinline__ void gla2_phase(LAS unsigned char* lds, const bf16_t* PB, bf16_t* MRG, float* SLOC, float* DSEG, const float* gn, int vwg, int G, bf16_t* MRGO, const float* LRp, const float* wgp, const float* bgp) {
    const int tid = otid(), lane = tid & 63, w = __builtin_amdgcn_readfirstlane(tid >> 6), lr = lane & 15, lq = lane >> 4;
    LAS unsigned char *QG = lds + G2_QG, *KR = lds + G2_KR, *KGT = lds + G2_KGT, *VT = lds + G2_VT, *AT = lds + G2_AT;
    LAS float* DEC = (LAS float*)(lds + G2_DEC); LAS float* TOT = (LAS float*)(lds + G2_TOT); LAS float* RED = (LAS float*)(lds + G2_RED); LAS float* DSG = (LAS float*)(lds + G2_DSG); LAS float* LRS = (LAS float*)(lds + G2_LRS);
    const __amdgpu_buffer_rsrc_t rPB = mk_rsrc(PB), rMR = mk_rsrc(MRG), rSL = mk_rsrc(SLOC), rMO = mk_rsrc(MRGO), rLR = mk_rsrc(LRp);
    for (int item = vwg; item < 256; item += G) {
        const int seg = item & 7, bh = item >> 3, h = bh & 3, b = bh >> 2;
        const size_t tb = (size_t)b * SEQ + (size_t)seg * 512;
        f32x4 st[8][2];
#pragma unroll
        for (int dt = 0; dt < 8; ++dt) { st[dt][0] = (f32x4){0.f, 0.f, 0.f, 0.f}; st[dt][1] = (f32x4){0.f, 0.f, 0.f, 0.f}; }
        __syncthreads();
        if (PASS == 2 && seg > 0) {
            if (tid < 128) for (int sp = 0; sp < seg; ++sp) DSG[sp * 128 + tid] = DSEG[(size_t)(bh * 8 + sp) * 128 + tid];
            const unsigned slo = (unsigned)lane * 4u;
            float cur[64];
            { const int slu = ((bh * 8 + 0) * 8 + w) * 64 * 256;
#pragma unroll
              for (int q = 0; q < 64; ++q) cur[q] = __uint_as_float(__builtin_amdgcn_raw_buffer_load_b32(rSL, slo, slu + q * 256, 0)); }
            __syncthreads();
            for (int sp = 0; sp < seg; ++sp) {
                const int slun = ((bh * 8 + (sp + 1 < seg ? sp + 1 : sp)) * 8 + w) * 64 * 256;
#pragma unroll
                for (int dt = 0; dt < 8; ++dt) { const f32x4 dc = *(const LAS f32x4*)(DSG + sp * 128 + 16 * dt + 4 * lq);
#pragma unroll
                    for (int vt = 0; vt < 2; ++vt)
#pragma unroll
                        for (int r = 0; r < 4; ++r) { const int q = (dt * 2 + vt) * 4 + r; st[dt][vt][r] = st[dt][vt][r] * dc[r] + cur[q];
                            cur[q] = __uint_as_float(__builtin_amdgcn_raw_buffer_load_b32(rSL, slo, slun + q * 256, 0)); } }
            }
            __syncthreads();
        }
        const int dp = tid & 63, part = w, tp = tid & 31, cgp = tid >> 5;
        const int qub = (int)(((tb + 8 * part) * NB + h * 128) * 2);
        const unsigned qvo = (unsigned)dp * 4u;
        const int vub = (int)((tb * NB + 1024 + h * 256) * 2);
        const unsigned vvo = ((unsigned)(2 * tp) * NB + 16u * cgp) * 2u;
        const unsigned evo = ((unsigned)lr * NB + 4u * lq) * 2u, mvo = ((unsigned)lr * D + 4u * lq) * 2u;
        float segdec0 = 1.f, segdec1 = 1.f;
        float wg0[16], wg1[16], bg0 = 0.f, bg1 = 0.f; u32x4 lrn = {0u, 0u, 0u, 0u};
        if (PASS == 1) {
#pragma unroll
            for (int r = 0; r < 16; ++r) { const f32x2_t t = *(const f32x2_t*)(wgp + r * 512 + h * 128 + 2 * dp); wg0[r] = t.x; wg1[r] = t.y; }
            { const f32x2_t t = *(const f32x2_t*)(bgp + h * 128 + 2 * dp); bg0 = t.x; bg1 = t.y; }
            if (tid < 256) lrn = __builtin_amdgcn_raw_buffer_load_b128(rLR, (unsigned)tid * 16u, (int)(tb * 64), 0);
        }
        unsigned rq[8], rk[8], rg[8]; u32x4 rv[4];
#pragma unroll
        for (int e = 0; e < 8; ++e) { const int p = qub + e * NB * 2; if (PASS == 2) rq[e] = __builtin_amdgcn_raw_buffer_load_b32(rPB, qvo, p, 0); rk[e] = __builtin_amdgcn_raw_buffer_load_b32(rPB, qvo, p + 1024, 0); if (PASS == 2) rg[e] = __builtin_amdgcn_raw_buffer_load_b32(rPB, qvo, p + 6144, 0); }
#pragma unroll
        for (int e = 0; e < 2; ++e) { const int p = vub + e * NB * 2; rv[2 * e] = __builtin_amdgcn_raw_buffer_load_b128(rPB, vvo, p, 0); rv[2 * e + 1] = __builtin_amdgcn_raw_buffer_load_b128(rPB, vvo, p + 16, 0); }
        for (int c = 0; c < 8; ++c) {
            if (PASS == 1) {
                if (tid < 256) *(LAS u32x4*)(LRS + tid * 4) = lrn;
                if (c + 1 < 8 && tid < 256) lrn = __builtin_amdgcn_raw_buffer_load_b128(rLR, (unsigned)tid * 16u, (int)((tb + 64 * (c + 1)) * 64), 0);
                LDS_BAR0();
#pragma unroll
                for (int e = 0; e < 8; ++e) {
                    const LAS f32x4* lp = (const LAS f32x4*)(LRS + (8 * part + e) * 16);
                    float s0 = bg0, s1 = bg1;
#pragma unroll
                    for (int q = 0; q < 4; ++q) { const f32x4 lv = lp[q];
#pragma unroll
                        for (int j = 0; j < 4; ++j) { s0 += lv[j] * wg0[4 * q + j]; s1 += lv[j] * wg1[4 * q + j]; } }
                    const float a0 = (fminf(s0, 0.f) - __logf(1.f + __expf(-fabsf(s0)))) * 0.0625f, a1 = (fminf(s1, 0.f) - __logf(1.f + __expf(-fabsf(s1)))) * 0.0625f;
                    rg[e] = pg8::cvt_pk_bf16(a0, a1);
                    __builtin_amdgcn_raw_buffer_store_b32(rg[e], rPB, qvo, qub + (64 * c + e) * NB * 2 + 6144, 0);
                }
            }
            float G0[8], G1[8]; float run0 = 0.f, run1 = 0.f;
#pragma unroll
            for (int e = 0; e < 8; ++e) { run0 += bflo(rg[e]); run1 += bfhi(rg[e]); G0[e] = run0; G1[e] = run1; }
            *(LAS f32x2_t*)(TOT + part * 128 + 2 * dp) = (f32x2_t){run0, run1};
            __syncthreads();
            float off0 = 0.f, off1 = 0.f, gl0 = 0.f, gl1 = 0.f;
#pragma unroll
            for (int p = 0; p < 8; ++p) { const f32x2_t t = *(const LAS f32x2_t*)(TOT + p * 128 + 2 * dp); gl0 += t.x; gl1 += t.y; if (p < part) { off0 += t.x; off1 += t.y; } }
            const float dec0 = __expf(gl0), dec1 = __expf(gl1);
            if (part == 0) { *(LAS f32x2_t*)(DEC + 2 * dp) = (f32x2_t){dec0, dec1}; segdec0 *= dec0; segdec1 *= dec1; }
            { float kgA[8], kgB[8];
#pragma unroll
              for (int e = 0; e < 8; ++e) {
                  const float eg0 = __expf(G0[e] + off0), eg1 = __expf(G1[e] + off1), ie0 = __builtin_amdgcn_rcpf(eg0), ie1 = __builtin_amdgcn_rcpf(eg1);
                  const float kr0 = bflo(rk[e]) * ie0, kr1 = bfhi(rk[e]) * ie1; kgA[e] = kr0 * dec0; kgB[e] = kr1 * dec1;
                  if (PASS == 2) { *(LAS unsigned*)(QG + (8 * part + e) * 272 + dp * 4) = pg8::cvt_pk_bf16(bflo(rq[e]) * eg0, bfhi(rq[e]) * eg1);
                                   *(LAS unsigned*)(KR + (8 * part + e) * 272 + dp * 4) = pg8::cvt_pk_bf16(kr0, kr1); } }
              u32x4 wa, wb; wa.x = pg8::cvt_pk_bf16(kgA[0], kgA[1]); wa.y = pg8::cvt_pk_bf16(kgA[2], kgA[3]); wa.z = pg8::cvt_pk_bf16(kgA[4], kgA[5]); wa.w = pg8::cvt_pk_bf16(kgA[6], kgA[7]);
              wb.x = pg8::cvt_pk_bf16(kgB[0], kgB[1]); wb.y = pg8::cvt_pk_bf16(kgB[2], kgB[3]); wb.z = pg8::cvt_pk_bf16(kgB[4], kgB[5]); wb.w = pg8::cvt_pk_bf16(kgB[6], kgB[7]);
              *(LAS u32x4*)(KGT + (2 * dp) * 144 + part * 16) = wa; *(LAS u32x4*)(KGT + (2 * dp + 1) * 144 + part * 16) = wb; }
            { const u32x4 va0 = rv[0], va1 = rv[1], vb0 = rv[2], vb1 = rv[3];
              const unsigned av[8] = {va0.x, va0.y, va0.z, va0.w, va1.x, va1.y, va1.z, va1.w}, bv[8] = {vb0.x, vb0.y, vb0.z, vb0.w, vb1.x, vb1.y, vb1.z, vb1.w};
              LAS unsigned char* vp = VT + (16 * cgp) * 144 + tp * 4;
#pragma unroll
              for (int m = 0; m < 8; ++m) { *(LAS unsigned*)(vp + (2 * m) * 144) = (av[m] & 0xffffu) | (bv[m] << 16); *(LAS unsigned*)(vp + (2 * m + 1) * 144) = (av[m] >> 16) | (bv[m] & 0xffff0000u); } }
            __syncthreads();
            if (c + 1 < 8)
            {
#pragma unroll
                for (int e = 0; e < 8; ++e) { const int p = qub + (64 * (c + 1) + e) * NB * 2; if (PASS == 2) rq[e] = __builtin_amdgcn_raw_buffer_load_b32(rPB, qvo, p, 0); rk[e] = __builtin_amdgcn_raw_buffer_load_b32(rPB, qvo, p + 1024, 0); if (PASS == 2) rg[e] = __builtin_amdgcn_raw_buffer_load_b32(rPB, qvo, p + 6144, 0); }
#pragma unroll
                for (int e = 0; e < 2; ++e) { const int p = vub + (64 * (c + 1) + e) * NB * 2; rv[2 * e] = __builtin_amdgcn_raw_buffer_load_b128(rPB, vvo, p, 0); rv[2 * e + 1] = __builtin_amdgcn_raw_buffer_load_b128(rPB, vvo, p + 16, 0); }
            }
            f32x4 oacc[4][2];
            if (PASS == 2) {
#pragma unroll
                for (int u2 = 0; u2 < 2; ++u2) {
                    const int id = 2 * w + u2, it = id >> 2, jt = id & 3;
                    f32x4 a = {0.f, 0.f, 0.f, 0.f};
                    if (jt <= it) {
#pragma unroll
                        for (int ks = 0; ks < 4; ++ks) {
                            const bf16x8 kf = *(const LAS bf16x8*)(KR + (16 * jt + lr) * 272 + (32 * ks + 8 * lq) * 2);
                            const bf16x8 qf = *(const LAS bf16x8*)(QG + (16 * it + lr) * 272 + (32 * ks + 8 * lq) * 2);
                            a = mfma16(kf, qf, a);
                        }
                        if (jt == it) {
#pragma unroll
                            for (int r = 0; r < 4; ++r) if (4 * lq + r > lr) a[r] = 0.f; }
                    }
                    u32x2 pk; pk.x = pg8::cvt_pk_bf16(a[0], a[1]); pk.y = pg8::cvt_pk_bf16(a[2], a[3]);
                    *(LAS u32x2*)(AT + (16 * it + lr) * 144 + (16 * jt + 4 * lq) * 2) = pk;
                }
#pragma unroll
                for (int it = 0; it < 4; ++it) { oacc[it][0] = (f32x4){0.f, 0.f, 0.f, 0.f}; oacc[it][1] = (f32x4){0.f, 0.f, 0.f, 0.f}; }
#pragma unroll
                for (int ks = 0; ks < 4; ++ks) {
                    bf16x8 sf[2];
#pragma unroll
                    for (int vt = 0; vt < 2; ++vt) { u32x4 t; t.x = pg8::cvt_pk_bf16(st[2 * ks][vt][0], st[2 * ks][vt][1]); t.y = pg8::cvt_pk_bf16(st[2 * ks][vt][2], st[2 * ks][vt][3]);
                        t.z = pg8::cvt_pk_bf16(st[2 * ks + 1][vt][0], st[2 * ks + 1][vt][1]); t.w = pg8::cvt_pk_bf16(st[2 * ks + 1][vt][2], st[2 * ks + 1][vt][3]); sf[vt] = __builtin_bit_cast(bf16x8, t); }
#pragma unroll
                    for (int it = 0; it < 4; ++it) {
                        const LAS unsigned char* qp = QG + (16 * it + lr) * 272 + (32 * ks + 4 * lq) * 2;
                        const bf16x4 qa = *(const LAS bf16x4*)qp, qb = *(const LAS bf16x4*)(qp + 32);
                        const bf16x8 qf = __builtin_shufflevector(qa, qb, 0, 1, 2, 3, 4, 5, 6, 7);
                        oacc[it][0] = mfma16(sf[0], qf, oacc[it][0]); oacc[it][1] = mfma16(sf[1], qf, oacc[it][1]);
                    }
                }
                __syncthreads();
            }
            u32x2 er[4][2], ey[4][2];
            __builtin_amdgcn_sched_barrier(0);
            if (PASS == 2) {
#pragma unroll
                for (int it = 0; it < 4; ++it)
#pragma unroll
                    for (int vt = 0; vt < 2; ++vt) { const size_t tku = tb + 64 * c + 16 * it; const int colu = h * 256 + 32 * w + 16 * vt;
                        const int pu = (int)((tku * NB + 2048 + colu) * 2), mu = (int)((tku * D + colu) * 2);
                        er[it][vt] = __builtin_amdgcn_raw_buffer_load_b64(rPB, evo, pu, 0); ey[it][vt] = __builtin_amdgcn_raw_buffer_load_b64(rMR, mvo, mu, 0); }
            }
            bf16x8 vf[2][2];
#pragma unroll
            for (int vt = 0; vt < 2; ++vt)
#pragma unroll
                for (int ks = 0; ks < 2; ++ks) vf[vt][ks] = *(const LAS bf16x8*)(VT + (32 * w + 16 * vt + lr) * 144 + (32 * ks + 8 * lq) * 2);
            if (PASS == 2) {
#pragma unroll
                for (int it = 0; it < 4; ++it)
#pragma unroll
                    for (int ks = 0; ks < 2; ++ks) { if (ks == 1 && it < 2) continue;
                        const bf16x8 af = *(const LAS bf16x8*)(AT + (16 * it + lr) * 144 + (32 * ks + 8 * lq) * 2);
                        oacc[it][0] = mfma16(vf[0][ks], af, oacc[it][0]); oacc[it][1] = mfma16(vf[1][ks], af, oacc[it][1]); }
            }
            u32x2 opk[4][2];
            if (PASS == 2) {
#pragma unroll
                for (int it = 0; it < 4; ++it) { float s = 0.f;
#pragma unroll
                    for (int vt = 0; vt < 2; ++vt)
#pragma unroll
                        for (int r = 0; r < 4; ++r) s += oacc[it][vt][r] * oacc[it][vt][r];
                    s += __shfl_xor(s, 16); s += __shfl_xor(s, 32);
                    if (lq == 0) RED[w * 64 + 16 * it + lr] = s; }
#pragma unroll
                for (int it = 0; it < 4; ++it)
#pragma unroll
                    for (int vt = 0; vt < 2; ++vt) { opk[it][vt].x = pg8::cvt_pk_bf16(oacc[it][vt][0], oacc[it][vt][1]); opk[it][vt].y = pg8::cvt_pk_bf16(oacc[it][vt][2], oacc[it][vt][3]); }
            }
            __builtin_amdgcn_sched_barrier(0);
#pragma unroll
            for (int dt = 0; dt < 8; ++dt) {
                const f32x4 dc = *(const LAS f32x4*)(DEC + 16 * dt + 4 * lq);
                st[dt][0] = st[dt][0] * dc; st[dt][1] = st[dt][1] * dc;
#pragma unroll
                for (int ks = 0; ks < 2; ++ks) { const bf16x8 kf = *(const LAS bf16x8*)(KGT + (16 * dt + lr) * 144 + (32 * ks + 8 * lq) * 2);
                    st[dt][0] = mfma16(kf, vf[0][ks], st[dt][0]); st[dt][1] = mfma16(kf, vf[1][ks], st[dt][1]); }
            }
            __builtin_amdgcn_sched_barrier(0);
            if (PASS == 2) {
                __syncthreads();
#pragma unroll
                for (int half = 0; half < 2; ++half) {
#pragma unroll
                    for (int it2 = 0; it2 < 2; ++it2) { const int it = 2 * half + it2; float ss = 0.f;
#pragma unroll
                        for (int ww = 0; ww < 8; ++ww) ss += RED[ww * 64 + 16 * it + lr];
                        const float rstd = 1.0f / sqrtf(ss * (1.f / 256.f) + EPS);
#pragma unroll
                        for (int vt = 0; vt < 2; ++vt) { const size_t tku = tb + 64 * c + 16 * it; const int colu = h * 256 + 32 * w + 16 * vt;
                            const f32x4 gnv = *(const f32x4*)(gn + 32 * w + 16 * vt + 4 * lq);
                            const f32x4 ou = {bflo(opk[it][vt].x), bfhi(opk[it][vt].x), bflo(opk[it][vt].y), bfhi(opk[it][vt].y)};
                            const f32x4 o = ou * rstd * gnv;
                            const float y0 = bflo(ey[it][vt].x) + o[0] * bflo(er[it][vt].x), y1 = bfhi(ey[it][vt].x) + o[1] * bfhi(er[it][vt].x);
                            const float y2 = bflo(ey[it][vt].y) + o[2] * bflo(er[it][vt].y), y3 = bfhi(ey[it][vt].y) + o[3] * bfhi(er[it][vt].y);
                            u32x2 ow; ow.x = pg8::cvt_pk_bf16(y0, y1); ow.y = pg8::cvt_pk_bf16(y2, y3);
                            __builtin_amdgcn_raw_buffer_store_b64(ow, rMO, mvo, (int)((tku * D + colu) * 2), 0); } }
                }
            }
        }
        if (PASS == 1) {
            const int slu = ((bh * 8 + seg) * 8 + w) * 64 * 256; const unsigned slo = (unsigned)lane * 4u;
#pragma unroll
            for (int dt = 0; dt < 8; ++dt)
#pragma unroll
                for (int vt = 0; vt < 2; ++vt)
#pragma unroll
                    for (int r = 0; r < 4; ++r) __builtin_amdgcn_raw_buffer_store_b32(__float_as_uint(st[dt][vt][r]), rSL, slo, slu + ((dt * 2 + vt) * 4 + r) * 256, 0);
            if (part == 0) { DSEG[(size_t)(bh * 8 + seg) * 128 + 2 * dp] = segdec0; DSEG[(size_t)(bh * 8 + seg) * 128 + 2 * dp + 1] = segdec1; }
        }
    }
}

typedef __attribute__((address_space(1))) unsigned gu32;
#define XB_TMO      128
#define XB_XCNT(j)  (256  + 64 * (j))
#define XB_XSUB(j)  (1280 + 64 * (j))
#define XB_XGEN(j)  (2304 + 64 * (j))
#define XB_TOP      3328
#define XB_TOPGEN   3392
#define XCD_BAR_WORDS 3456
#define XB_SPIN_CAP (1u << 22)

__device__ __forceinline__ unsigned xb_ld(unsigned* p)              { return __hip_atomic_load(p, __ATOMIC_RELAXED, __HIP_MEMORY_SCOPE_AGENT); }
__device__ __forceinline__ unsigned xb_add(unsigned* p, unsigned v) { return __hip_atomic_fetch_add(p, v, __ATOMIC_RELAXED, __HIP_MEMORY_SCOPE_AGENT); }
__device__ __forceinline__ unsigned xb_xcc_id() { return (unsigned)__builtin_amdgcn_s_getreg((3 << 11) | 20) & 0xFu; }
#define XB_SPIN(cond, bar) do { unsigned _sp = 0; while (cond) { __builtin_amdgcn_s_sleep(1); \
    if ((++_sp & 255u) == 0u) { if (xb_ld(&(bar)[XB_TMO])) break; if (_sp > XB_SPIN_CAP) { atomicAdd(&(bar)[XB_TMO], 1u); break; } } } } while (0)

struct XcdBarrier {
    unsigned* bar; unsigned x;
    volatile LAS unsigned* st;
};

__device__ __forceinline__ XcdBarrier xcd_barrier_post(unsigned* bar, volatile LAS unsigned* st) {
    XcdBarrier b; b.bar = bar; b.x = xb_xcc_id(); b.st = st;
    if (threadIdx.x == 0) (void)xb_add(&bar[XB_XCNT(b.x)], 1u);
    return b;
}
__device__ __forceinline__ void xcd_barrier_complete(unsigned* bar, unsigned x, unsigned& nloc, unsigned& nx) {
    const unsigned G = gridDim.x * gridDim.y * gridDim.z;
    unsigned sum, cnt, mine, sp = 0u;
    for (;;) {
        sum = 0u; cnt = 0u; mine = 0u;
#pragma unroll
        for (unsigned j = 0; j < 16; ++j) { const unsigned c = xb_ld(&bar[XB_XCNT(j)]); sum += c; cnt += (c > 0u) ? 1u : 0u; mine = (j == x) ? c : mine; }
        if (sum == G) break;
        __builtin_amdgcn_s_sleep(1);
        if ((++sp & 255u) == 0u) { if (xb_ld(&bar[XB_TMO])) break; if (sp > XB_SPIN_CAP) { atomicAdd(&bar[XB_TMO], 1u); break; } }
    }
    nloc = mine > 0u ? mine : 1u; nx = cnt > 0u ? cnt : 1u;
}

__device__ __forceinline__ void xcd_barrier(const XcdBarrier& b) {
    asm volatile("s_waitcnt vmcnt(0)" ::: "memory");
    __syncthreads();
    if (threadIdx.x == 0) {
        unsigned* bar = b.bar;
        __builtin_amdgcn_s_waitcnt(0);
        unsigned nloc = b.st[0], nx = b.st[1];
        if (nloc == 0u) { xcd_barrier_complete(bar, b.x, nloc, nx); b.st[0] = nloc; b.st[1] = nx; }
        const unsigned old = xb_add(&bar[XB_XSUB(b.x)], 1u);
        const unsigned gen = old / nloc;
        if (old + 1u == (gen + 1u) * nloc) {
            __builtin_amdgcn_fence(__ATOMIC_RELEASE, "agent");
            asm volatile("s_waitcnt vmcnt(0)" ::: "memory");
            const unsigned og = xb_add(&bar[XB_TOP], 1u);
            const unsigned tg = og / nx;
            if (og + 1u == (tg + 1u) * nx) xb_add(&bar[XB_TOPGEN], 1u);
            else XB_SPIN(xb_ld(&bar[XB_TOPGEN]) == tg, bar);
            __builtin_amdgcn_fence(__ATOMIC_ACQUIRE, "agent");
            xb_add(&bar[XB_XGEN(b.x)], 1u);
            asm volatile("s_waitcnt vmcnt(0)" ::: "memory");
        } else {
            XB_SPIN(xb_ld(&bar[XB_XGEN(b.x)]) == gen, bar);
            __builtin_amdgcn_fence(__ATOMIC_ACQUIRE, "agent");
            asm volatile("s_waitcnt vmcnt(0)" ::: "memory");
        }
    }
    __syncthreads();
}

struct Args { const float* in[18]; float* out; unsigned char* ws; int ph_lo, ph_hi; };
constexpr int PH_PER_LAYER = 14;
constexpr int NPH = 2 * PH_PER_LAYER + 1;

__global__ void __launch_bounds__(512, 2) mega_fwd(Args a) {
    extern __shared__ __attribute__((aligned(16))) unsigned char lds_raw[];
    LAS unsigned char* lds = (LAS unsigned char*)lds_raw;
    cg::grid_group grid = cg::this_grid();
    volatile LAS unsigned* MISC = (volatile LAS unsigned*)(lds + LDS_BYTES - 512);
    if (threadIdx.x < 32) MISC[threadIdx.x] = 0u;
    __syncthreads();
    XcdBarrier bar = xcd_barrier_post((unsigned*)(a.ws + WS_CTL) + 4096, MISC + 8);
    grid.sync();
    const int G = gridDim.x, bx = blockIdx.x;
    const int vwg = (G % 8 == 0) ? (bx % 8) * (G / 8) + bx / 8 : bx;
    unsigned char* ws = a.ws;
    float* MOD = (float*)(ws + WS_MOD);
    bf16_t* H = (bf16_t*)(ws + WS_H); bf16_t* MRG = (bf16_t*)(ws + WS_MRG); bf16_t* PROJ = (bf16_t*)(ws + WS_PROJ);
    float* X = a.out;
    for (int ph0 = a.ph_lo; ph0 < a.ph_hi; ++ph0) {
        const int ph = ph0;
        if (ph == NPH - 1) { final_norm_phase(X, H, a.in[17], vwg, G); }
        else {
            const int l = ph / PH_PER_LAYER, p = ph % PH_PER_LAYER;
            const float* modl = MOD + (size_t)l * 8 * NMOD; unsigned char* wsw = ws + WS_W + (size_t)l * WS_WSTRIDE;
            if (p == 0 && l == 1) {   }
            else if (p == 0) {
                if (l == 0) mod_phase(lds, a.in[1], a.in[2], a.in[3], MOD, vwg, G);
                __syncthreads();
                LayerW L; L.f1in = a.in[5] + (size_t)l * D * NFF2; L.f1out = a.in[6] + (size_t)l * FF * D; L.mixin = a.in[8] + (size_t)l * D * INC; L.wgate = a.in[10] + (size_t)l * 16 * 512;
                L.mixout = a.in[13] + (size_t)l * D * D; L.f2in = a.in[15] + (size_t)l * D * NFF2; L.f2out = a.in[16] + (size_t)l * FF * D;
                wconv_phase(lds, L, wsw, vwg, G);
            } else if (p == 1 || p == 4 || p == 11) {
                const int q = (p == 1) ? 0 : (p == 4 ? 1 : 2);
                const float* gain = a.in[q == 0 ? 4 : (q == 1 ? 7 : 14)] + (size_t)l * D;
                const bool from_input = (l == 0 && p <= 4);
                norm_phase(from_input ? a.in[0] : X, X, H, (l == 0 && p == 1) ? 0 : 1, gain, modl + (3 * q) * D, modl + (3 * q + 1) * D, vwg, G);
            } else if (p == 2 || p == 12) {
                pg8::Gemm g{H, (const bf16_t*)(wsw + (p == 2 ? W_1IN : W_2IN)), T, NFF2, D}; pg8::StaticOrder S; S.init(T, NFF2, G, bx);
                EpiSwiGLU E{PROJ};
                pg8::gemm_phase<EpiSwiGLU, pg8::StaticOrder, true, true>(lds, g, S, E);
            } else if (p == 3 || p == 10 || p == 13) {
                const bf16_t* Aop = (p == 10) ? MRG : PROJ; const int K = (p == 10) ? D : FF;
                const bf16_t* Bop = (const bf16_t*)(wsw + (p == 3 ? W_1OUT : (p == 10 ? W_O : W_2OUT)));
                pg8::Gemm g{Aop, Bop, T, D, K}; pg8::StaticOrder S; S.init(T, D, G, bx);
                EpiResid E{H, modl + (p == 3 ? 2 : (p == 10 ? 5 : 8)) * D, p == 10 ? 1.0f : 0.5f};
                pg8::gemm_phase<EpiResid, pg8::StaticOrder, true, true>(lds, g, S, E);
            } else if (p == 5 || p == 7) {
                const int N = (p == 5) ? NAG : NBG;
                pg8::Gemm g{H, (const bf16_t*)(wsw + (p == 5 ? W_A : W_B)), T, N, D}; pg8::StaticOrder S; S.init(T, N, G, bx);
                EpiProj E{PROJ, p == 5 ? NA : NB, p == 5 ? 0 : 1, (float*)(ws + WS_LR)};
                pg8::gemm_phase<EpiProj, pg8::StaticOrder, true, true>(lds, g, S, E);
            } else if (p == 6) {
                LayerW Ln; { const int ln = 1; Ln.f1in = a.in[5] + (size_t)ln * D * NFF2; Ln.f1out = a.in[6] + (size_t)ln * FF * D; Ln.mixin = a.in[8] + (size_t)ln * D * INC; Ln.wgate = a.in[10] + (size_t)ln * 16 * 512;
                    Ln.mixout = a.in[13] + (size_t)ln * D * D; Ln.f2in = a.in[15] + (size_t)ln * D * NFF2; Ln.f2out = a.in[16] + (size_t)ln * FF * D; }
                LayerW Lc; Lc.f1in = a.in[5]; Lc.f1out = a.in[6]; Lc.mixin = a.in[8]; Lc.wgate = a.in[10]; Lc.mixout = a.in[13]; Lc.f2in = a.in[15]; Lc.f2out = a.in[16];
                att_phase(lds, PROJ, MRG, a.in[9] + l * 16, vwg, G, l == 0 ? 1 : 0, Lc, ws + WS_W, Ln, ws + WS_W + WS_WSTRIDE);
            } else if (p == 8) {
                gla2_phase<1>(lds, PROJ, MRG, (float*)H, (float*)H + (size_t)8 * 1024 * 1024, a.in[12] + (size_t)l * 256, vwg, G, MRG, (const float*)(ws + WS_LR), a.in[10] + (size_t)l * 16 * 512, a.in[11] + (size_t)l * 512);
            } else if (p == 9) {
                gla2_phase<2>(lds, PROJ, MRG, (float*)H, (float*)H + (size_t)8 * 1024 * 1024, a.in[12] + (size_t)l * 256, vwg, G, MRG, (const float*)(ws + WS_LR), a.in[10] + (size_t)l * 16 * 512, a.in[11] + (size_t)l * 512);
            }
        }
        if (ph == PH_PER_LAYER) continue;
        if (ph0 + 1 < a.ph_hi) xcd_barrier(bar);
    }
}

extern "C" void kernel_launch(void* const* d_in, const int* in_sizes, int n_in, void* d_out, int out_size, void* d_ws, size_t ws_size, hipStream_t stream) {
    static int grid = 0;
    if (grid == 0) {
        int dev = 0, cus = 0, per_cu = 0;
        hipGetDevice(&dev); hipDeviceGetAttribute(&cus, hipDeviceAttributeMultiprocessorCount, dev);
        if (hipFuncSetAttribute((const void*)mega_fwd, hipFuncAttributeMaxDynamicSharedMemorySize, LDS_BYTES) != hipSuccess) fprintf(stderr, "hipFuncSetAttribute failed\n");
        if (hipOccupancyMaxActiveBlocksPerMultiprocessor(&per_cu, (const void*)mega_fwd, 512, LDS_BYTES) != hipSuccess || per_cu < 1) per_cu = 1;
        (void)hipGetLastError();
        grid = cus * 1;
        if (ws_size < 512 * MiB) fprintf(stderr, "kernel_launch: workspace %zu smaller than expected\n", ws_size);
    }
    (void)hipMemsetAsync((char*)d_ws + WS_CTL, 0, CTL_BYTES, stream);
    Args a{};
    for (int i = 0; i < 18; ++i) a.in[i] = (const float*)d_in[i];
    a.out = (float*)d_out; a.ws = (unsigned char*)d_ws;
    a.ph_lo = 0; a.ph_hi = NPH;
    void* args[] = {&a};
    hipError_t e = hipLaunchCooperativeKernel((const void*)mega_fwd, dim3(grid), dim3(512), args, LDS_BYTES, stream);
    if (e != hipSuccess) fprintf(stderr, "cooperative launch failed: %s (grid %d)\n", hipGetErrorString(e), grid);
}
```
